# Optimizing an MI355X kernel written in HIP

```python
import math
import jax, jax.numpy as jnp
from jax import lax
import numpy as np

D_MODEL = 1024
BATCH = 32
SEQ = 256
DEPTH = 4
DEC_BATCH = 2
DEC_SEQ = 1024
PAST_LEN = 256

GRID_W = 64
N_MIXERS = 2
N_DIFF = (DEPTH + 1) // 2
N_MLA = DEPTH // 2
N_MOD = 9
D_FF = 2816
DIFF_HEADS = 8
DIFF_HD = 64
DIFF_VD = 2 * DIFF_HD
MLA_HEADS = 16
MLA_NOPE = 64
MLA_ROPE = 32
MLA_QK = MLA_NOPE + MLA_ROPE
MLA_VD = 64
Q_RANK = 768
KV_RANK = 256
ROPE_THETA = 10000.0
EPS = 1e-6
Q_BLOCK = 128
DIFF_SCALE = DIFF_HD ** -0.5
MLA_SCALE = MLA_QK ** -0.5

kernel_name = "diffmla_macaron_adaln_prefix_step"


def rms_norm(x, g):
    x32 = x.astype(jnp.float32)
    y = x32 * lax.rsqrt(jnp.mean(x32 * x32, axis=-1, keepdims=True) + EPS)
    return y.astype(x.dtype) * g


def grid_positions(n_tokens):
    rows = n_tokens // GRID_W
    row = jnp.repeat(jnp.arange(rows, dtype=jnp.int32), GRID_W)
    col = jnp.tile(jnp.arange(GRID_W, dtype=jnp.int32), rows)
    return row, col


def _rope_half(x, pos):
    n = x.shape[-1]
    freqs = ROPE_THETA ** (-jnp.arange(0, n, 2, dtype=jnp.float32) / n)
    ang = pos.astype(jnp.float32)[:, None] * freqs[None, :]
    shape = (1, pos.shape[0]) + (1,) * (x.ndim - 3) + (n // 2,)
    cos = jnp.cos(ang).reshape(shape).astype(x.dtype)
    sin = jnp.sin(ang).reshape(shape).astype(x.dtype)
    x1, x2 = x[..., : n // 2], x[..., n // 2:]
    return jnp.concatenate([x1 * cos - x2 * sin, x2 * cos + x1 * sin], axis=-1)


def rope_2d(x, row, col):
    r = x.shape[-1] // 2
    return jnp.concatenate([_rope_half(x[..., :r], row), _rope_half(x[..., r:], col)], axis=-1)


def rope_tail(x, row, col):
    return jnp.concatenate([x[..., :MLA_NOPE], rope_2d(x[..., MLA_NOPE:], row, col)], axis=-1)


def sweep_query_blocks(fn, *qs):
    B, L = qs[0].shape[:2]
    nb = L // Q_BLOCK
    blocks = tuple(jnp.moveaxis(q.reshape((B, nb, Q_BLOCK) + q.shape[2:]), 1, 0) for q in qs)
    out = lax.map(lambda qb: fn(*qb), blocks)
    return jnp.moveaxis(out, 0, 1).reshape((B, L) + out.shape[3:])


def softmax_f32(s, scale):
    return jax.nn.softmax(s.astype(jnp.float32) * scale, axis=-1)


def diff_attention(q, k, v, lam, scale):
    k1, k2 = k[..., 0, :], k[..., 1, :]

    def block(qb):
        a1 = softmax_f32(jnp.einsum('bqhd,bkhd->bhqk', qb[..., 0, :], k1), scale)
        a2 = softmax_f32(jnp.einsum('bqhd,bkhd->bhqk', qb[..., 1, :], k2), scale)
        a = a1 - lam * a2
        return jnp.einsum('bhqk,bkhv->bqhv', a.astype(v.dtype), v)

    return sweep_query_blocks(block, q)


def mha(q, k, v, scale):
    def block(qb):
        a = softmax_f32(jnp.einsum('bqhd,bkhd->bhqk', qb, k), scale)
        return jnp.einsum('bhqk,bkhv->bqhv', a.astype(v.dtype), v)

    return sweep_query_blocks(block, q)


def diff_qkv(h, w_qkv, q_g, k_g):
    B, L, _ = h.shape
    q, k, v = jnp.split(h @ w_qkv, 3, axis=-1)
    q = rms_norm(q.reshape(B, L, DIFF_HEADS, 2, DIFF_HD), q_g)
    k = rms_norm(k.reshape(B, L, DIFF_HEADS, 2, DIFF_HD), k_g)
    v = v.reshape(B, L, DIFF_HEADS, DIFF_VD)
    return q, k, v


def lambda_value(lam_p, layer_idx):
    lam_init = 0.8 - 0.6 * math.exp(-0.3 * layer_idx)
    lp = lam_p.astype(jnp.float32)
    lam = jnp.exp(jnp.sum(lp[0] * lp[1])) - jnp.exp(jnp.sum(lp[2] * lp[3])) + lam_init
    return lam, lam_init


def diff_out(o, lam_init, subln_g, w_o):
    B, L = o.shape[:2]
    o = rms_norm(o, subln_g) * (1.0 - lam_init)
    return o.reshape(B, L, DIFF_HEADS * DIFF_VD) @ w_o


def mla_down(h, w_down, qa_g, kva_g):
    cq, ckv, kpe = jnp.split(h @ w_down, [Q_RANK, Q_RANK + KV_RANK], axis=-1)
    return rms_norm(cq, qa_g), rms_norm(ckv, kva_g), kpe


def mla_queries(cq, w_q_up, q_g):
    B, L = cq.shape[:2]
    return rms_norm((cq @ w_q_up).reshape(B, L, MLA_HEADS, MLA_QK), q_g)


def mla_keys_values(ckv, kpe, w_kv_up, k_g):
    B, L = ckv.shape[:2]
    kv = (ckv @ w_kv_up).reshape(B, L, MLA_HEADS, MLA_NOPE + MLA_VD)
    k_nope, v = kv[..., :MLA_NOPE], kv[..., MLA_NOPE:]
    k_pe = jnp.broadcast_to(kpe[:, :, None, :], (B, L, MLA_HEADS, MLA_ROPE))
    k = rms_norm(jnp.concatenate([k_nope, k_pe], axis=-1), k_g)
    return k, v


def mla_out(o, w_o):
    B, L = o.shape[:2]
    return o.reshape(B, L, MLA_HEADS * MLA_VD) @ w_o


def modulation(cond, w_mod, b_mod):
    m = jax.nn.silu(cond) @ w_mod + b_mod
    return m.reshape(cond.shape[0], 1, N_MOD, D_MODEL)


def modulate(x, g, shift, scale):
    return rms_norm(x, g) * (1.0 + scale) + shift


def swiglu(h, w_in, w_out):
    g, u = jnp.split(h @ w_in, 2, axis=-1)
    return (jax.nn.silu(g) * u) @ w_out


def macaron_layer(x, mod, norm_g, w_in, w_out, mixer):
    m = [mod[:, :, i] for i in range(N_MOD)]
    x = x + m[2] * (0.5 * swiglu(modulate(x, norm_g[0], m[0], m[1]), w_in[0], w_out[0]))
    out, aux = mixer(modulate(x, norm_g[1], m[3], m[4]))
    x = x + m[5] * out
    x = x + m[8] * (0.5 * swiglu(modulate(x, norm_g[2], m[6], m[7]), w_in[1], w_out[1]))
    return x, aux


def setup_inputs(seed: int = 0) -> dict:
    key = jax.random.key(seed)
    ks = jax.random.split(key, 27)
    f32 = jnp.float32
    D = D_MODEL

    def nrm(k, shape, s):
        return jax.random.normal(k, shape, f32) * s

    def gain(k, shape):
        return 1.0 + 0.02 * jax.random.normal(k, shape, f32)

    return {
        "x_prompt": nrm(ks[0], (BATCH, SEQ, D), 1.0),
        "x_sample": nrm(ks[1], (DEC_BATCH, DEC_SEQ, D), 1.0),
        "c": nrm(ks[2], (DEC_BATCH, D), 1.0),
        "cache_diff_k": nrm(ks[3], (DEC_BATCH, N_DIFF, PAST_LEN, DIFF_HEADS, 2, DIFF_HD), 1.0),
        "cache_diff_v": nrm(ks[4], (DEC_BATCH, N_DIFF, PAST_LEN, DIFF_HEADS, DIFF_VD), 1.0),
        "cache_mla_ckv": nrm(ks[5], (DEC_BATCH, N_MLA, PAST_LEN, KV_RANK), 1.0),
        "cache_mla_kpe": nrm(ks[6], (DEC_BATCH, N_MLA, PAST_LEN, MLA_ROPE), 1.0),
        "c_ctx": nrm(ks[7], (D,), 1.0),
        "w_mod": nrm(ks[8], (DEPTH, D, N_MOD * D), 0.5 * D ** -0.5),
        "b_mod": nrm(ks[9], (DEPTH, N_MOD * D), 0.02),
        "norm_g": gain(ks[10], (DEPTH, 3, D)),
        "ffn_w_in": nrm(ks[11], (DEPTH, 2, D, 2 * D_FF), D ** -0.5),
        "ffn_w_out": nrm(ks[12], (DEPTH, 2, D_FF, D), D_FF ** -0.5),
        "diff_w_qkv": nrm(ks[13], (N_DIFF, D, 3 * DIFF_HEADS * DIFF_VD), D ** -0.5),
        "diff_q_norm": gain(ks[14], (N_DIFF, DIFF_HD)),
        "diff_k_norm": gain(ks[15], (N_DIFF, DIFF_HD)),
        "diff_lambda": nrm(ks[16], (N_DIFF, 4, DIFF_HD), 0.1),
        "diff_subln": gain(ks[17], (N_DIFF, DIFF_VD)),
        "diff_w_o": nrm(ks[18], (N_DIFF, DIFF_HEADS * DIFF_VD, D), (DIFF_HEADS * DIFF_VD) ** -0.5),
        "mla_w_down": nrm(ks[19], (N_MLA, D, Q_RANK + KV_RANK + MLA_ROPE), D ** -0.5),
        "mla_q_a_norm": gain(ks[20], (N_MLA, Q_RANK)),
        "mla_kv_a_norm": gain(ks[21], (N_MLA, KV_RANK)),
        "mla_w_q_up": nrm(ks[22], (N_MLA, Q_RANK, MLA_HEADS * MLA_QK), Q_RANK ** -0.5),
        "mla_w_kv_up": nrm(ks[23], (N_MLA, KV_RANK, MLA_HEADS * (MLA_NOPE + MLA_VD)), KV_RANK ** -0.5),
        "mla_q_norm": gain(ks[24], (N_MLA, MLA_QK)),
        "mla_k_norm": gain(ks[25], (N_MLA, MLA_QK)),
        "mla_w_o": nrm(ks[26], (N_MLA, MLA_HEADS * MLA_VD, D), (MLA_HEADS * MLA_VD) ** -0.5),
    }


def reference(x_prompt, x_sample, c, cache_diff_k, cache_diff_v, cache_mla_ckv, cache_mla_kpe, c_ctx,
              w_mod, b_mod, norm_g, ffn_w_in, ffn_w_out,
              diff_w_qkv, diff_q_norm, diff_k_norm, diff_lambda, diff_subln, diff_w_o,
              mla_w_down, mla_q_a_norm, mla_kv_a_norm, mla_w_q_up, mla_w_kv_up, mla_q_norm, mla_k_norm, mla_w_o):
    row, col = grid_positions(x_sample.shape[1])
    xp, xs = x_prompt, x_sample
    new_diff_k, new_diff_v, new_mla_ckv, new_mla_kpe = [], [], [], []
    for l in range(DEPTH):
        j = l // N_MIXERS
        mod_ctx = modulation(c_ctx[None, :], w_mod[l], b_mod[l])
        mod_lat = modulation(c, w_mod[l], b_mod[l])
        if l % N_MIXERS == 0:
            w_qkv, qg, kg = diff_w_qkv[j], diff_q_norm[j], diff_k_norm[j]
            sub_g, w_o = diff_subln[j], diff_w_o[j]
            lam, lam_init = lambda_value(diff_lambda[j], l)

            def ctx_mixer(h):
                q, k, v = diff_qkv(h, w_qkv, qg, kg)
                o = diff_attention(q, k, v, lam, DIFF_SCALE)
                return diff_out(o, lam_init, sub_g, w_o), (k, v)

            def lat_mixer(h):
                q, k, v = diff_qkv(h, w_qkv, qg, kg)
                q, k = rope_2d(q, row, col), rope_2d(k, row, col)
                k_all = jnp.concatenate([cache_diff_k[:, j], k], axis=1)
                v_all = jnp.concatenate([cache_diff_v[:, j], v], axis=1)
                o = diff_attention(q, k_all, v_all, lam, DIFF_SCALE)
                return diff_out(o, lam_init, sub_g, w_o), ()

            xp, (k_ctx, v_ctx) = macaron_layer(xp, mod_ctx, norm_g[l], ffn_w_in[l], ffn_w_out[l], ctx_mixer)
            new_diff_k.append(k_ctx)
            new_diff_v.append(v_ctx)
        else:
            w_down, qag, kvag = mla_w_down[j], mla_q_a_norm[j], mla_kv_a_norm[j]
            w_q_up, w_kv_up, qg, kg, w_o = mla_w_q_up[j], mla_w_kv_up[j], mla_q_norm[j], mla_k_norm[j], mla_w_o[j]

            def ctx_mixer(h):
                cq, ckv, kpe = mla_down(h, w_down, qag, kvag)
                q = mla_queries(cq, w_q_up, qg)
                k, v = mla_keys_values(ckv, kpe, w_kv_up, kg)
                return mla_out(mha(q, k, v, MLA_SCALE), w_o), (ckv, kpe)

            def lat_mixer(h):
                cq, ckv, kpe = mla_down(h, w_down, qag, kvag)
                q = rope_tail(mla_queries(cq, w_q_up, qg), row, col)
                k_lat, v_lat = mla_keys_values(ckv, kpe, w_kv_up, kg)
                k_lat = rope_tail(k_lat, row, col)
                k_ctx, v_ctx = mla_keys_values(cache_mla_ckv[:, j], cache_mla_kpe[:, j], w_kv_up, kg)
                k_all = jnp.concatenate([k_ctx, k_lat], axis=1)
                v_all = jnp.concatenate([v_ctx, v_lat], axis=1)
                return mla_out(mha(q, k_all, v_all, MLA_SCALE), w_o), ()

            xp, (ckv_ctx, kpe_ctx) = macaron_layer(xp, mod_ctx, norm_g[l], ffn_w_in[l], ffn_w_out[l], ctx_mixer)
            new_mla_ckv.append(ckv_ctx)
            new_mla_kpe.append(kpe_ctx)
        xs, _ = macaron_layer(xs, mod_lat, norm_g[l], ffn_w_in[l], ffn_w_out[l], lat_mixer)
    return (xp, xs, jnp.stack(new_diff_k, axis=1), jnp.stack(new_diff_v, axis=1),
            jnp.stack(new_mla_ckv, axis=1), jnp.stack(new_mla_kpe, axis=1))
```

```cpp
#include <hip/hip_runtime.h>
#include <hip/hip_cooperative_groups.h>
#include <cstdio>
#include <cstdint>
namespace cg = cooperative_groups;
#define RESID_BATCH_M 2
namespace pg8 {
#define PG8_LAS __attribute__((address_space(3)))
typedef unsigned short bf16_t;
typedef short bf16x8 __attribute__((ext_vector_type(8)));
typedef float f32x4 __attribute__((ext_vector_type(4)));
typedef unsigned u32x4 __attribute__((ext_vector_type(4)));
constexpr int BM = 256, BK = 64, HALF = 128, HTB = HALF * BK * 2  , STAGE_BYTES = 8 * HTB, NXCD = 8, WGM = 8;

__host__ __device__ __forceinline__ int lds_byte(int r, int c) { const int st = (r >> 4) * 2 + (c >> 5), rr = r & 15, cc = c & 31, ob = rr * 64 + cc * 2; return st * 1024 + (ob ^ (((ob >> 9) & 1) << 5)); }
__host__ __device__ __forceinline__ void stage_rc(int b, int& R, int& C) { const int st = b / 1024, sb = b % 1024, swz = sb ^ (((sb >> 9) & 1) << 5); R = (st >> 1) * 16 + swz / 64; C = (st & 1) * 32 + (swz % 64) / 2; }
__host__ __device__ __forceinline__ int perm32(int rho) { const int n = rho >> 4, i = rho & 15; return 8 * (i >> 2) + 4 * n + (i & 3); }

struct Unit { int pm, pn; };
struct Gemm { const bf16_t* A; const bf16_t* Bt; int M, N, K; };

struct StaticOrder {
    int nM, nN, nwg, G, c;
    __host__ __device__ void init(int M, int N, int G_, int c_) { nM = M / BM; nN = N / BM; nwg = nM * nN; G = G_; c = c_; }
    __host__ __device__ bool next(int i, Unit& u) const {
        const long L = (long)i * G + c; if (L >= nwg) return false;
        int wgid = (int)L; { const int q = nwg / NXCD, r = nwg % NXCD, xcd = wgid % NXCD, off = wgid / NXCD; wgid = (xcd < r ? xcd * (q + 1) : r * (q + 1) + (xcd - r) * q) + off; }
        const int nig = WGM * nN, gid = wgid / nig, fm = gid * WGM, gsz = (nM - fm) < WGM ? (nM - fm) : WGM;
        u.pm = fm + ((wgid % nig) % gsz); u.pn = (wgid % nig) / gsz; return true;
    }
    __device__ __forceinline__ void a_ready(const Unit&) const {}
    __device__ __forceinline__ void done(const Unit&) const {}
};

__device__ __forceinline__ unsigned cvt_pk_bf16(float lo, float hi) { unsigned r; asm volatile("v_cvt_pk_bf16_f32 %0, %1, %2" : "=v"(r) : "v"(lo), "v"(hi)); return r; }
typedef float f32x2 __attribute__((ext_vector_type(2)));
template <class Epi, class Sched, bool ALIGN_EPI = false, bool SP2 = false>
__device__ __forceinline__ void gemm_phase(PG8_LAS unsigned char* lds, const Gemm g, const Sched& S, const Epi& E) {
    int tid_o = threadIdx.x; asm volatile("" : "+v"(tid_o));
    const int tid = tid_o, wid = __builtin_amdgcn_readfirstlane(tid >> 6), lane = tid & 63, wr = wid >> 2, wc = wid & 3, fr = lane & 15, fq = lane >> 4;
    int K_o = g.K; asm volatile("" : "+s"(K_o)); const int K = K_o, nt = K / BK;
    unsigned voffA[2], voffB[2];
#pragma unroll
    for (int i = 0; i < 2; ++i) { int R, C; stage_rc(tid * 16 + i * 8192, R, C); const int Rb = Epi::PERM ? ((R & ~31) + perm32(R & 31)) : R;
        voffA[i] = (unsigned)(R * K + C) * 2u; voffB[i] = (unsigned)(Rb * K + C) * 2u; }
    const size_t kstep = (size_t)(BK * 2);
    const size_t hstep = (size_t)HALF * K * 2;
    const size_t tstep = 2 * hstep;
    const unsigned ldsw = (unsigned)wid * 1024u;
    const int aoff = lds_byte(wr * 64 + fr, fq * 8), boff = lds_byte(wc * 32 + fr, fq * 8);
#define PG8_SA(b, h) (((b) * 2 + (h)) * HTB)
#define PG8_SB(b, h) ((4 + (b) * 2 + (h)) * HTB)
#define PG8_STAGE(bufoff, gbase, voff) do { _Pragma("unroll") for (int _i = 0; _i < 2; ++_i) \
        __builtin_amdgcn_global_load_lds((const unsigned*)((const char*)(gbase) + (voff)[_i]), (PG8_LAS unsigned*)(lds + (bufoff) + ldsw + _i * 8192), 16, 0, 0); } while (0)
#define PG8_LDA(dst, b, h) do { _Pragma("unroll") for (int m = 0; m < 4; ++m) _Pragma("unroll") for (int k = 0; k < 2; ++k) dst[m][k] = *(const PG8_LAS bf16x8*)(lds + PG8_SA(b, h) + aoff + m * 2048 + k * 1024); } while (0)
#define PG8_LDB(dst, b, h) do { _Pragma("unroll") for (int n = 0; n < 2; ++n) _Pragma("unroll") for (int k = 0; k < 2; ++k) dst[n][k] = *(const PG8_LAS bf16x8*)(lds + PG8_SB(b, h) + boff + n * 2048 + k * 1024); } while (0)
#define PG8_MMA(ai, bj, At, Bt) do { __builtin_amdgcn_s_setprio(1); _Pragma("unroll") for (int m = 0; m < 4; ++m) _Pragma("unroll") for (int n = 0; n < 2; ++n) _Pragma("unroll") for (int k = 0; k < 2; ++k) \
        acc[ai][bj][m][n] = __builtin_amdgcn_mfma_f32_16x16x32_bf16(Bt[n][k], At[m][k], acc[ai][bj][m][n], 0, 0, 0); __builtin_amdgcn_s_setprio(0); } while (0)
#define PG8_WAIT_V(n) asm volatile("s_waitcnt vmcnt(" #n ")" ::: "memory")
#define PG8_WAIT_L(n) asm volatile("s_waitcnt lgkmcnt(" #n ")" ::: "memory")
#define PG8_BAR __builtin_amdgcn_s_barrier()
#define PG8_SCHED __builtin_amdgcn_sched_barrier(0)
    Unit cur, nxt; int ui = 0;
    if (!S.next(0, cur)) return;
    f32x4 acc[2][2][4][2];
#pragma unroll
    for (int a = 0; a < 2; ++a)
#pragma unroll
        for (int b = 0; b < 2; ++b)
#pragma unroll
            for (int m = 0; m < 4; ++m)
#pragma unroll
                for (int n = 0; n < 2; ++n) acc[a][b][m][n] = (f32x4){0.f, 0.f, 0.f, 0.f};
    bf16x8 At[4][2], B0[2][2], B1[2][2];
    const char* cA = (const char*)g.A + (size_t)cur.pm * tstep; const char* cB = (const char*)g.Bt + (size_t)cur.pn * tstep;
    S.a_ready(cur);
    if constexpr (SP2) {
        PG8_STAGE(PG8_SB(0, 0), cB, voffB); PG8_STAGE(PG8_SB(0, 1), cB + hstep, voffB); PG8_STAGE(PG8_SA(0, 0), cA, voffA); PG8_STAGE(PG8_SA(0, 1), cA + hstep, voffA);
        if (wr == 1) PG8_BAR;
        PG8_WAIT_V(2); PG8_BAR;
        PG8_STAGE(PG8_SB(1, 0), cB + kstep, voffB); PG8_STAGE(PG8_SA(1, 0), cA + kstep, voffA); PG8_STAGE(PG8_SB(1, 1), cB + hstep + kstep, voffB);
        PG8_WAIT_V(6); PG8_BAR;
    } else {
        PG8_STAGE(PG8_SB(0, 0), cB, voffB); PG8_STAGE(PG8_SA(0, 0), cA, voffA); PG8_STAGE(PG8_SB(0, 1), cB + hstep, voffB); PG8_STAGE(PG8_SA(0, 1), cA + hstep, voffA);
        if (wr == 1) PG8_BAR;
        PG8_WAIT_V(4); PG8_BAR;
        PG8_STAGE(PG8_SB(1, 0), cB + kstep, voffB); PG8_STAGE(PG8_SA(1, 0), cA + kstep, voffA); PG8_STAGE(PG8_SB(1, 1), cB + hstep + kstep, voffB);
        PG8_WAIT_V(6); PG8_BAR;
    }
    for (;;) {
        const bool has_next = S.next(ui + 1, nxt);
        const char* nA = has_next ? (const char*)g.A + (size_t)nxt.pm * tstep : cA; const char* nB = has_next ? (const char*)g.Bt + (size_t)nxt.pn * tstep : cB;
        for (int t = 0; t < nt; t += 2) {
            const bool last = (t == nt - 2);
            const char* a1 = cA + (size_t)(t + 1) * kstep;
            const char* a2 = last ? nA : cA + (size_t)(t + 2) * kstep; const char* b2 = last ? nB : cB + (size_t)(t + 2) * kstep;
            const char* a3 = a2 + kstep; const char* b3 = b2 + kstep;
            if (last && has_next) S.a_ready(nxt);
            if constexpr (SP2) {
            PG8_LDB(B0, 0, 0); PG8_LDB(B1, 0, 1); PG8_SCHED; PG8_LDA(At, 0, 0); PG8_STAGE(PG8_SA(1, 1), a1 + hstep, voffA);
            PG8_WAIT_V(8); PG8_WAIT_L(0); PG8_BAR; PG8_MMA(0, 0, At, B0); PG8_MMA(0, 1, At, B1); PG8_BAR; PG8_SCHED;
            PG8_LDA(At, 0, 1); PG8_STAGE(PG8_SB(0, 0), b2, voffB); PG8_STAGE(PG8_SB(0, 1), b2 + hstep, voffB); PG8_STAGE(PG8_SA(0, 0), a2, voffA);
            PG8_WAIT_V(8); PG8_WAIT_L(0); PG8_BAR; PG8_MMA(1, 0, At, B0); PG8_MMA(1, 1, At, B1); PG8_BAR; PG8_SCHED;
            PG8_LDB(B0, 1, 0); PG8_LDB(B1, 1, 1); PG8_SCHED; PG8_LDA(At, 1, 0); PG8_STAGE(PG8_SA(0, 1), a2 + hstep, voffA);
            PG8_WAIT_V(8); PG8_WAIT_L(0); PG8_BAR; PG8_MMA(0, 0, At, B0); PG8_MMA(0, 1, At, B1); PG8_BAR; PG8_SCHED;
            PG8_LDA(At, 1, 1); PG8_STAGE(PG8_SB(1, 0), b3, voffB); PG8_STAGE(PG8_SB(1, 1), b3 + hstep, voffB); PG8_STAGE(PG8_SA(1, 0), a3, voffA);
            PG8_WAIT_V(8); PG8_WAIT_L(0); PG8_BAR; PG8_MMA(1, 0, At, B0); PG8_MMA(1, 1, At, B1); PG8_BAR; PG8_SCHED;
            } else {
            PG8_LDB(B0, 0, 0); PG8_SCHED; PG8_LDA(At, 0, 0); PG8_STAGE(PG8_SA(1, 1), a1 + hstep, voffA);
            PG8_WAIT_L(8); PG8_BAR; PG8_WAIT_L(0); PG8_MMA(0, 0, At, B0); PG8_BAR; PG8_SCHED;
            PG8_LDB(B1, 0, 1); PG8_STAGE(PG8_SB(0, 0), b2, voffB);
            PG8_BAR; PG8_WAIT_L(0); PG8_MMA(0, 1, At, B1); PG8_BAR;
            PG8_LDA(At, 0, 1); PG8_STAGE(PG8_SA(0, 0), a2, voffA);
            PG8_BAR; PG8_WAIT_L(0); PG8_MMA(1, 0, At, B0); PG8_BAR; PG8_SCHED;
            PG8_STAGE(PG8_SB(0, 1), b2 + hstep, voffB);
            PG8_WAIT_V(6); PG8_BAR; PG8_MMA(1, 1, At, B1); PG8_BAR;
            PG8_LDB(B0, 1, 0); PG8_SCHED; PG8_LDA(At, 1, 0); PG8_STAGE(PG8_SA(0, 1), a2 + hstep, voffA);
            PG8_WAIT_L(8); PG8_BAR; PG8_WAIT_L(0); PG8_MMA(0, 0, At, B0); PG8_BAR; PG8_SCHED;
            PG8_LDB(B1, 1, 1); PG8_STAGE(PG8_SB(1, 0), b3, voffB);
            PG8_BAR; PG8_WAIT_L(0); PG8_MMA(0, 1, At, B1); PG8_BAR;
            PG8_LDA(At, 1, 1); PG8_STAGE(PG8_SA(1, 0), a3, voffA);
            PG8_BAR; PG8_WAIT_L(0); PG8_MMA(1, 0, At, B0); PG8_BAR; PG8_SCHED;
            PG8_STAGE(PG8_SB(1, 1), b3 + hstep, voffB);
            PG8_WAIT_V(6); PG8_BAR; PG8_MMA(1, 1, At, B1); PG8_BAR;
            }
        }
        if constexpr (ALIGN_EPI) { if (wr == 0) PG8_BAR; }
        if constexpr (!Epi::AFTER_DRAIN) { E(acc, cur, wr, wc, fr, fq); S.done(cur); }
        if (!has_next) break;
#pragma unroll
        for (int a = 0; a < 2; ++a)
#pragma unroll
            for (int b = 0; b < 2; ++b)
#pragma unroll
                for (int m = 0; m < 4; ++m)
#pragma unroll
                    for (int n = 0; n < 2; ++n) acc[a][b][m][n] = (f32x4){0.f, 0.f, 0.f, 0.f};
        cur = nxt; cA = nA; cB = nB; ++ui;
        if constexpr (ALIGN_EPI) { if (wr == 1) PG8_BAR; }
    }
    PG8_WAIT_V(0);
    if constexpr (!ALIGN_EPI) { if (wr == 0) PG8_BAR; }
    PG8_BAR;
    if constexpr (Epi::AFTER_DRAIN) { E.fused(acc, cur, wr, wc, fr, fq, lds, wid, lane); S.done(cur); }
#undef PG8_SA
#undef PG8_SB
#undef PG8_STAGE
#undef PG8_LDA
#undef PG8_LDB
#undef PG8_MMA
#undef PG8_WAIT_V
#undef PG8_WAIT_L
#undef PG8_BAR
#undef PG8_SCHED
}
}

#define GAS __attribute__((address_space(1)))
#define LAS __attribute__((address_space(3)))
typedef unsigned short bf16;
typedef unsigned u32x4 __attribute__((ext_vector_type(4)));
typedef unsigned u32x2 __attribute__((ext_vector_type(2)));
typedef float f32x4 __attribute__((ext_vector_type(4)));
typedef float f32x2 __attribute__((ext_vector_type(2)));
typedef short bf16x8 __attribute__((ext_vector_type(8)));
typedef short s16x4 __attribute__((ext_vector_type(4)));

constexpr int DM = 1024, NCTX = 8192, NLAT = 2048, NTOK = 10240, NKV = 10752, DFF = 2816, NMOD = 9216;
constexpr int NWAVES = 8, NTHREADS = 512;
constexpr float EPS = 1e-6f;
constexpr int LDS_BYTES = 147456;

constexpr size_t OUT_X = 0;
constexpr size_t OUT_DK = (size_t)NTOK * DM;
constexpr size_t OUT_DV = OUT_DK + (size_t)32 * 2 * 256 * 1024;
constexpr size_t OUT_CKV = OUT_DV + (size_t)32 * 2 * 256 * 1024;
constexpr size_t OUT_KPE = OUT_CKV + (size_t)32 * 2 * 256 * 256;
constexpr size_t OUT_TOTAL = OUT_KPE + (size_t)32 * 2 * 256 * 32;

constexpr size_t al4k(size_t x) { return (x + 4095) & ~(size_t)4095; }
constexpr size_t OFF_CTL = 0;
constexpr size_t OFF_MOD = 1u << 20;
constexpr size_t OFF_TABD = OFF_MOD + al4k((size_t)4 * 3 * NMOD * 4);
constexpr size_t OFF_TABM = OFF_TABD + al4k(64 * 16 * 2 * 4);
constexpr size_t SZ_WIN = (size_t)2 * DFF * DM * 2, SZ_WOUT = (size_t)DM * DFF * 2;
constexpr size_t OFF_WIN = OFF_TABM + al4k(64 * 8 * 2 * 4);
constexpr size_t OFF_WOUT = OFF_WIN + 8 * SZ_WIN;
constexpr size_t SZ_DQKV = (size_t)3072 * 1024 * 2, SZ_WO = (size_t)1024 * 1024 * 2, SZ_MDOWN = (size_t)1280 * 1024 * 2, SZ_MQUP = (size_t)1536 * 768 * 2, SZ_MKVUP = (size_t)2048 * 256 * 2;
constexpr size_t OFF_DQKV = OFF_WOUT + 8 * SZ_WOUT;
constexpr size_t OFF_DWO = OFF_DQKV + 2 * SZ_DQKV;
constexpr size_t OFF_MDOWN = OFF_DWO + 2 * SZ_WO;
constexpr size_t OFF_MQUP = OFF_MDOWN + 2 * SZ_MDOWN;
constexpr size_t OFF_MKVUP = OFF_MQUP + 2 * SZ_MQUP;
constexpr size_t OFF_MWO = OFF_MKVUP + 2 * SZ_MKVUP;
constexpr size_t OFF_H = OFF_MWO + 2 * SZ_WO;
constexpr size_t OFF_ACT = OFF_H + (size_t)NTOK * DM * 2;
constexpr size_t OFF_Q = OFF_ACT + (size_t)NTOK * DFF * 2;
constexpr size_t OFF_K = OFF_Q + (size_t)NTOK * 1536 * 2;
constexpr size_t OFF_V = OFF_K + (size_t)NKV * 1536 * 2;
constexpr size_t OFF_O = OFF_V + (size_t)NKV * 1024 * 2;
constexpr size_t OFF_KC = OFF_O + (size_t)NTOK * DM * 2;
constexpr size_t OFF_VC = OFF_KC + (size_t)2 * 512 * 1024 * 2;
constexpr size_t OFF_DOWN = OFF_VC + (size_t)2 * 512 * 1024 * 2;
constexpr size_t OFF_CQ = OFF_DOWN + (size_t)NTOK * 1056 * 4;
constexpr size_t SZ_CKV = (size_t)NKV * 256 * 2, SZ_KPE = (size_t)NKV * 32 * 4, SZ_KPSS = al4k((size_t)NKV * 4);
constexpr size_t OFF_CKV = OFF_CQ + (size_t)NTOK * 768 * 2;
constexpr size_t OFF_KPE = OFF_CKV + 2 * SZ_CKV;
constexpr size_t OFF_KPSS = OFF_KPE + 2 * SZ_KPE;
constexpr size_t OFF_SS = OFF_KPSS + 2 * SZ_KPSS;
constexpr size_t OFF_SHW = OFF_SS + (size_t)12 * NTOK * 4;
constexpr size_t WS_END = OFF_SHW + (size_t)12 * 3 * 5632 * 4;

struct Args {
    const float* x_prompt; const float* x_sample; const float* c; const float* cache_diff_k; const float* cache_diff_v; const float* cache_mla_ckv; const float* cache_mla_kpe; const float* c_ctx;
    const float* w_mod; const float* b_mod; const float* norm_g; const float* ffn_w_in; const float* ffn_w_out;
    const float* diff_w_qkv; const float* diff_q_norm; const float* diff_k_norm; const float* diff_lambda; const float* diff_subln; const float* diff_w_o;
    const float* mla_w_down; const float* mla_q_a_norm; const float* mla_kv_a_norm; const float* mla_w_q_up; const float* mla_w_kv_up; const float* mla_q_norm; const float* mla_k_norm; const float* mla_w_o;
    float* out; unsigned char* ws;
};

typedef const Args __attribute__((address_space(4))) CArgs;
__device__ __forceinline__ CArgs* KA() { CArgs* p = (CArgs*)__builtin_amdgcn_kernarg_segment_ptr(); asm volatile("" : "+s"(p)); return p; }
#define ARGS (*KA())
__device__ __forceinline__ int opaque_tid() { int t = threadIdx.x; asm volatile("" : "+v"(t)); return t; }
__device__ __forceinline__ unsigned f2bf(float f) { unsigned u = __builtin_bit_cast(unsigned, f); return (u + 0x7fffu + ((u >> 16) & 1u)) >> 16; }
__device__ __forceinline__ unsigned pk2(float lo, float hi) { return pg8::cvt_pk_bf16(lo, hi); }
__device__ __forceinline__ float bf2f(unsigned short b) { return __builtin_bit_cast(float, (unsigned)b << 16); }
__device__ __forceinline__ float wave_sum(float v) {
#pragma unroll
    for (int o = 1; o < 64; o <<= 1) v += __shfl_xor(v, o);
    return v;
}
__device__ __forceinline__ float quad_sum(float v) { v += __shfl_xor(v, 16); v += __shfl_xor(v, 32); return v; }
__device__ __forceinline__ float quad_max(float v) { v = fmaxf(v, __shfl_xor(v, 16)); v = fmaxf(v, __shfl_xor(v, 32)); return v; }
__device__ __forceinline__ float fast_silu(float g) { return g * __builtin_amdgcn_rcpf(1.f + __builtin_amdgcn_exp2f(-1.4426950408889634f * g)); }
__device__ __forceinline__ u32x4 pack8(const float* v) { u32x4 w; w.x = pk2(v[0], v[1]); w.y = pk2(v[2], v[3]); w.z = pk2(v[4], v[5]); w.w = pk2(v[6], v[7]); return w; }
__device__ __forceinline__ int tok_group(int row) { return row < NCTX ? 0 : 1 + ((row - NCTX) >> 10); }

#define EPI_VALS(v, ai, bj, m) float v[8]; { _Pragma("unroll") for (int _n = 0; _n < 2; ++_n) _Pragma("unroll") for (int _j = 0; _j < 4; ++_j) v[_n * 4 + _j] = acc[ai][bj][m][_n][_j]; }

#define EPI_NORMIN_DECL const float* ss; const float* shw;
#define EPI_NORMIN_SW(sw, u, wc, fq) float sw[2][8]; { const float* sp_ = shw + (size_t)tok_group((u).pm * 256) * 5632 + (u).pn * 256 + (wc) * 32 + 8 * (fq); \
    _Pragma("unroll") for (int bj_ = 0; bj_ < 2; ++bj_) { const f32x4 a_ = *(const f32x4*)(sp_ + bj_ * 128), b_ = *(const f32x4*)(sp_ + bj_ * 128 + 4); \
        sw[bj_][0] = a_.x; sw[bj_][1] = a_.y; sw[bj_][2] = a_.z; sw[bj_][3] = a_.w; sw[bj_][4] = b_.x; sw[bj_][5] = b_.y; sw[bj_][6] = b_.z; sw[bj_][7] = b_.w; } }
#define EPI_NORMIN_RSTD(rs, row0) float rs[2][4]; { _Pragma("unroll") for (int ai_ = 0; ai_ < 2; ++ai_) _Pragma("unroll") for (int m_ = 0; m_ < 4; ++m_) rs[ai_][m_] = ss[(row0) + ai_ * 128 + m_ * 16]; \
    _Pragma("unroll") for (int ai_ = 0; ai_ < 2; ++ai_) _Pragma("unroll") for (int m_ = 0; m_ < 4; ++m_) rs[ai_][m_] = __builtin_amdgcn_rsqf(rs[ai_][m_] * (1.f / DM) + EPS); }
#define EPI_NORMIN_APPLY(v, bj, rstd, sw) { _Pragma("unroll") for (int i_ = 0; i_ < 8; ++i_) v[i_] = v[i_] * (rstd) + sw[bj][i_]; }

struct EpiSwiglu {
    static constexpr bool PERM = true, AFTER_DRAIN = false;
    bf16* ACT; EPI_NORMIN_DECL
    __device__ __forceinline__ void operator()(const pg8::f32x4 (&acc)[2][2][4][2], const pg8::Unit& u, int wr, int wc, int fr, int fq) const {
        const int row0 = u.pm * 256 + wr * 64 + fr, col = u.pn * 128 + wc * 32 + 8 * fq;
        EPI_NORMIN_SW(sw, u, wc, fq);
        EPI_NORMIN_RSTD(rsv, row0);
#pragma unroll
        for (int ai = 0; ai < 2; ++ai)
#pragma unroll
            for (int m = 0; m < 4; ++m) {
                EPI_VALS(g, ai, 0, m); EPI_VALS(uu, ai, 1, m);
                const float rstd = rsv[ai][m];
                EPI_NORMIN_APPLY(g, 0, rstd, sw); EPI_NORMIN_APPLY(uu, 1, rstd, sw);
                float r[8];
#pragma unroll
                for (int i = 0; i < 8; ++i) r[i] = fast_silu(g[i]) * uu[i];
                *(u32x4*)(ACT + (size_t)(row0 + ai * 128 + m * 16) * DFF + col) = pack8(r);
            }
    }
};

struct EpiResid {
    static constexpr bool PERM = true, AFTER_DRAIN = false;
    const float* xp; const float* xs; float* out; const float* gate; float scale;
    const float* gnext; const float* scnext; float* ssnext; bf16* XG;
    __device__ __forceinline__ void operator()(const pg8::f32x4 (&acc)[2][2][4][2], const pg8::Unit& u, int wr, int wc, int fr, int fq) const {
        const int row0 = u.pm * 256 + wr * 64 + fr, cb = u.pn * 256 + wc * 32 + 8 * fq;
        const int grp = tok_group(u.pm * 256);
        float gv[2][8];
#pragma unroll
        for (int bj = 0; bj < 2; ++bj) { const f32x4 a = *(const f32x4*)(gate + (size_t)grp * NMOD + cb + bj * 128), b = *(const f32x4*)(gate + (size_t)grp * NMOD + cb + bj * 128 + 4);
            gv[bj][0] = a.x * scale; gv[bj][1] = a.y * scale; gv[bj][2] = a.z * scale; gv[bj][3] = a.w * scale; gv[bj][4] = b.x * scale; gv[bj][5] = b.y * scale; gv[bj][6] = b.z * scale; gv[bj][7] = b.w * scale; }
        const bool hasnext = gnext != nullptr;
        float gsv[2][8];
        if (hasnext) {
#pragma unroll
            for (int bj = 0; bj < 2; ++bj) { const f32x4 a = *(const f32x4*)(gnext + cb + bj * 128), b = *(const f32x4*)(gnext + cb + bj * 128 + 4);
                const f32x4 c = *(const f32x4*)(scnext + (size_t)grp * NMOD + cb + bj * 128), d = *(const f32x4*)(scnext + (size_t)grp * NMOD + cb + bj * 128 + 4);
                gsv[bj][0] = a.x * (1.f + c.x); gsv[bj][1] = a.y * (1.f + c.y); gsv[bj][2] = a.z * (1.f + c.z); gsv[bj][3] = a.w * (1.f + c.w);
                gsv[bj][4] = b.x * (1.f + d.x); gsv[bj][5] = b.y * (1.f + d.y); gsv[bj][6] = b.z * (1.f + d.z); gsv[bj][7] = b.w * (1.f + d.w); }
        }
#ifndef RESID_BATCH_M
#define RESID_BATCH_M 4
#endif
#pragma unroll
        for (int ai = 0; ai < 2; ++ai)
#pragma unroll
            for (int mb = 0; mb < 4; mb += RESID_BATCH_M) {
                f32x4 xl[RESID_BATCH_M][2][2];
#pragma unroll
                for (int mm = 0; mm < RESID_BATCH_M; ++mm) { const int row = row0 + ai * 128 + (mb + mm) * 16;
                    const float* xo = row < NCTX ? xp + (size_t)row * DM : xs + (size_t)(row - NCTX) * DM;
#pragma unroll
                    for (int bj = 0; bj < 2; ++bj) { xl[mm][bj][0] = *(const f32x4*)(xo + cb + bj * 128); xl[mm][bj][1] = *(const f32x4*)(xo + cb + bj * 128 + 4); } }
#pragma unroll
                for (int mm = 0; mm < RESID_BATCH_M; ++mm) {
                    const int m = mb + mm;
                    const int row = row0 + ai * 128 + m * 16;
                    float* o = out + (size_t)row * DM;
                    float ssl = 0.f;
#pragma unroll
                    for (int bj = 0; bj < 2; ++bj) {
                        EPI_VALS(v, ai, bj, m);
                        const f32x4 x0 = xl[mm][bj][0], x1 = xl[mm][bj][1];
                        float xn[8];
                        xn[0] = x0.x + gv[bj][0] * v[0]; xn[1] = x0.y + gv[bj][1] * v[1]; xn[2] = x0.z + gv[bj][2] * v[2]; xn[3] = x0.w + gv[bj][3] * v[3];
                        xn[4] = x1.x + gv[bj][4] * v[4]; xn[5] = x1.y + gv[bj][5] * v[5]; xn[6] = x1.z + gv[bj][6] * v[6]; xn[7] = x1.w + gv[bj][7] * v[7];
                        *(f32x4*)(o + cb + bj * 128) = (f32x4){xn[0], xn[1], xn[2], xn[3]}; *(f32x4*)(o + cb + bj * 128 + 4) = (f32x4){xn[4], xn[5], xn[6], xn[7]};
                        if (hasnext) {
#pragma unroll
                            for (int i = 0; i < 8; ++i) { ssl += xn[i] * xn[i]; xn[i] *= gsv[bj][i]; }
                            *(u32x4*)(XG + (size_t)row * DM + cb + bj * 128) = pack8(xn);
                        }
                    }
                    if (hasnext) { ssl = quad_sum(ssl); if (fq == 0) __hip_atomic_fetch_add(ssnext + row, ssl, __ATOMIC_RELAXED, __HIP_MEMORY_SCOPE_AGENT); }
                }
            }
    }
};

struct EpiDiffQKV {
    static constexpr bool PERM = true, AFTER_DRAIN = false;
    bf16* Q; bf16* K; bf16* V; const float* qg; const float* kg; const float* tabD; float* out_k; float* out_v; int j; EPI_NORMIN_DECL
    __device__ __forceinline__ void operator()(const pg8::f32x4 (&acc)[2][2][4][2], const pg8::Unit& u, int wr, int wc, int fr, int fq) const {
        const int row0 = u.pm * 256 + wr * 64 + fr;
        const int G = 4 * u.pn + wc, type = G >> 4, hc = G & 15;
        const bool lat = u.pm >= 32;
        EPI_NORMIN_SW(sw, u, wc, fq);
        EPI_NORMIN_RSTD(rsv, row0);
        float gain[2][8];
        if (type < 2) { const float* gp = type == 0 ? qg : kg;
#pragma unroll
            for (int bj = 0; bj < 2; ++bj)
#pragma unroll
                for (int i = 0; i < 8; ++i) gain[bj][i] = gp[32 * bj + 8 * fq + i]; }
#pragma unroll
        for (int ai = 0; ai < 2; ++ai)
#pragma unroll
            for (int m = 0; m < 4; ++m) {
                __builtin_amdgcn_sched_barrier(0);
                const int row = row0 + ai * 128 + m * 16;
                EPI_VALS(v0, ai, 0, m); EPI_VALS(v1, ai, 1, m);
                { const float rstd_in = rsv[ai][m]; EPI_NORMIN_APPLY(v0, 0, rstd_in, sw); EPI_NORMIN_APPLY(v1, 1, rstd_in, sw); }
                const size_t dcol = (size_t)hc * 64 + 8 * fq;
                if (type < 2) {
                    float ss = 0.f;
#pragma unroll
                    for (int i = 0; i < 8; ++i) ss += v0[i] * v0[i] + v1[i] * v1[i];
                    ss = quad_sum(ss);
                    const float rstd = __builtin_amdgcn_rsqf(ss * (1.f / 64.f) + EPS);
#pragma unroll
                    for (int i = 0; i < 8; ++i) { v0[i] = v0[i] * rstd * gain[0][i]; v1[i] = v1[i] * rstd * gain[1][i]; }
                    if (lat) {
                        const int t = (row - NCTX) & 1023, prow = t >> 6, pcol = t & 63;
                        const float* t0 = tabD + (size_t)(prow * 16 + 8 * (fq & 1)) * 2; const float* t1 = tabD + (size_t)(pcol * 16 + 8 * (fq & 1)) * 2;
#pragma unroll
                        for (int i = 0; i < 8; ++i) {
                            const float p0 = __shfl_xor(v0[i], 32), p1 = __shfl_xor(v1[i], 32);
                            const float c0 = t0[2 * i], s0 = t0[2 * i + 1], c1 = t1[2 * i], s1 = t1[2 * i + 1];
                            v0[i] = fq < 2 ? v0[i] * c0 - p0 * s0 : v0[i] * c0 + p0 * s0;
                            v1[i] = fq < 2 ? v1[i] * c1 - p1 * s1 : v1[i] * c1 + p1 * s1;
                        }
                    }
                    bf16* dst = (type == 0 ? Q : K) + (size_t)row * 1024 + dcol;
                    *(u32x4*)(dst) = pack8(v0); *(u32x4*)(dst + 32) = pack8(v1);
                    if (type == 1 && !lat) {
                        const int b = row >> 8, s = row & 255;
                        float* o = out_k + ((size_t)(b * 2 + j) * 256 + s) * 1024 + dcol;
                        *(f32x4*)(o) = (f32x4){v0[0], v0[1], v0[2], v0[3]}; *(f32x4*)(o + 4) = (f32x4){v0[4], v0[5], v0[6], v0[7]};
                        *(f32x4*)(o + 32) = (f32x4){v1[0], v1[1], v1[2], v1[3]}; *(f32x4*)(o + 36) = (f32x4){v1[4], v1[5], v1[6], v1[7]};
                    }
                } else {
                    bf16* dst = V + (size_t)row * 1024 + dcol;
                    *(u32x4*)(dst) = pack8(v0); *(u32x4*)(dst + 32) = pack8(v1);
                    if (!lat) {
                        const int b = row >> 8, s = row & 255;
                        float* o = out_v + ((size_t)(b * 2 + j) * 256 + s) * 1024 + dcol;
                        *(f32x4*)(o) = (f32x4){v0[0], v0[1], v0[2], v0[3]}; *(f32x4*)(o + 4) = (f32x4){v0[4], v0[5], v0[6], v0[7]};
                        *(f32x4*)(o + 32) = (f32x4){v1[0], v1[1], v1[2], v1[3]}; *(f32x4*)(o + 36) = (f32x4){v1[4], v1[5], v1[6], v1[7]};
                    }
                }
            }
    }
};

struct EpiDownRaw {
    static constexpr bool PERM = true, AFTER_DRAIN = false;
    float* DOWN; EPI_NORMIN_DECL
    __device__ __forceinline__ void operator()(const pg8::f32x4 (&acc)[2][2][4][2], const pg8::Unit& u, int wr, int wc, int fr, int fq) const {
        const int row0 = u.pm * 256 + wr * 64 + fr, cb = u.pn * 256 + wc * 32 + 8 * fq;
        EPI_NORMIN_SW(sw, u, wc, fq);
        EPI_NORMIN_RSTD(rsv, row0);
#pragma unroll
        for (int ai = 0; ai < 2; ++ai)
#pragma unroll
            for (int m = 0; m < 4; ++m) {
                const int row = row0 + ai * 128 + m * 16;
                float* o = DOWN + (size_t)row * 1056;
                const float rstd = rsv[ai][m];
#pragma unroll
                for (int bj = 0; bj < 2; ++bj) { const int c = cb + bj * 128;
                    if (c < 1056) { EPI_VALS(v, ai, bj, m); EPI_NORMIN_APPLY(v, bj, rstd, sw);
                        *(f32x4*)(o + c) = (f32x4){v[0], v[1], v[2], v[3]}; *(f32x4*)(o + c + 4) = (f32x4){v[4], v[5], v[6], v[7]}; } }
            }
    }
};

struct EpiBf16Plain {
    static constexpr bool PERM = true, AFTER_DRAIN = false;
    bf16* O; int ldc;
    __device__ __forceinline__ void operator()(const pg8::f32x4 (&acc)[2][2][4][2], const pg8::Unit& u, int wr, int wc, int fr, int fq) const {
        const int row0 = u.pm * 256 + wr * 64 + fr, cb = u.pn * 256 + wc * 32 + 8 * fq;
#pragma unroll
        for (int ai = 0; ai < 2; ++ai)
#pragma unroll
            for (int m = 0; m < 4; ++m) {
                bf16* o = O + (size_t)(row0 + ai * 128 + m * 16) * ldc + cb;
#pragma unroll
                for (int bj = 0; bj < 2; ++bj) { EPI_VALS(v, ai, bj, m); *(u32x4*)(o + bj * 128) = pack8(v); }
            }
    }
};

struct EpiKVup {
    static constexpr bool PERM = true, AFTER_DRAIN = false;
    bf16* KM; bf16* VM; const float* kg; const float* KPE; const float* KPSS; const float* tabM;
    __device__ __forceinline__ void operator()(const pg8::f32x4 (&acc)[2][2][4][2], const pg8::Unit& u, int wr, int wc, int fr, int fq) const {
        const int row0 = u.pm * 256 + wr * 64 + fr;
        const int G = 4 * u.pn + wc, head = G >> 1, part = G & 1;
        const bool lat = u.pm >= 32 && u.pm < 40;
        float kps[2][4];
        if (part == 0) {
#pragma unroll
            for (int ai_ = 0; ai_ < 2; ++ai_)
#pragma unroll
                for (int m_ = 0; m_ < 4; ++m_) kps[ai_][m_] = KPSS[row0 + ai_ * 128 + m_ * 16];
        }
        float gain[2][8];
        if (part == 0) {
#pragma unroll
            for (int bj = 0; bj < 2; ++bj)
#pragma unroll
                for (int i = 0; i < 8; ++i) gain[bj][i] = kg[32 * bj + 8 * fq + i];
        }
#pragma unroll
        for (int ai = 0; ai < 2; ++ai)
#pragma unroll
            for (int m = 0; m < 4; ++m) {
                __builtin_amdgcn_sched_barrier(0);
                const int row = row0 + ai * 128 + m * 16;
                EPI_VALS(v0, ai, 0, m); EPI_VALS(v1, ai, 1, m);
                if (part == 0) {
                    float ss = 0.f;
#pragma unroll
                    for (int i = 0; i < 8; ++i) ss += v0[i] * v0[i] + v1[i] * v1[i];
                    ss = quad_sum(ss) + kps[ai][m];
                    const float rstd = __builtin_amdgcn_rsqf(ss * (1.f / 96.f) + EPS);
#pragma unroll
                    for (int i = 0; i < 8; ++i) { v0[i] = v0[i] * rstd * gain[0][i]; v1[i] = v1[i] * rstd * gain[1][i]; }
                    bf16* dst = KM + (size_t)row * 1536 + head * 96 + 8 * fq;
                    *(u32x4*)(dst) = pack8(v0); *(u32x4*)(dst + 32) = pack8(v1);
                    const float* kp = KPE + (size_t)row * 32;
                    const f32x4 a0 = *(const f32x4*)(kp + 8 * fq), a1 = *(const f32x4*)(kp + 8 * fq + 4);
                    float mine[8] = {a0.x * rstd, a0.y * rstd, a0.z * rstd, a0.w * rstd, a1.x * rstd, a1.y * rstd, a1.z * rstd, a1.w * rstd};
                    if (lat) {
                        const int t = (row - NCTX) & 1023, pos = (fq >> 1) ? (t & 63) : (t >> 6);
                        const float* tb = tabM + (size_t)pos * 16;
#pragma unroll
                        for (int i = 0; i < 8; ++i) { const float pp = __shfl_xor(mine[i], 16), c = tb[2 * i], s = tb[2 * i + 1];
                            mine[i] = (fq & 1) == 0 ? mine[i] * c - pp * s : mine[i] * c + pp * s; }
                    }
                    *(u32x4*)(KM + (size_t)row * 1536 + head * 96 + 64 + 8 * fq) = pack8(mine);
                } else {
                    bf16* dst = VM + (size_t)row * 1024 + head * 64 + 8 * fq;
                    *(u32x4*)(dst) = pack8(v0); *(u32x4*)(dst + 32) = pack8(v1);
                }
            }
    }
};

__device__ __forceinline__ int rowmap(int mode, int c) {
    if (mode == 1) { return c < DFF ? 256 * (c >> 7) + (c & 127) : 256 * ((c - DFF) >> 7) + 128 + ((c - DFF) & 127); }
    if (mode == 2) { const int G = c >> 6, e = c & 63; return 256 * (G >> 2) + 128 * (e >> 5) + 32 * (G & 3) + (e & 31); }
    return c;
}
__device__ __forceinline__ void xpose_item(const float* W, int K, int N, bf16* WT, int mode, LAS float* scr, int item, int lane, const float* sh = nullptr, float* shw = nullptr) {
    const int nblk = N / 32, kb = item / nblk, nb = item % nblk, k0 = 64 * kb, n0 = 32 * nb;
    {
        float wv[32];
        const float* wsrc = W + (size_t)(k0 + (lane >> 5)) * N + n0 + (lane & 31);
#pragma unroll
        for (int i = 0; i < 32; ++i) wv[i] = __builtin_nontemporal_load(wsrc + (size_t)(2 * i) * N);
#pragma unroll
        for (int i = 0; i < 32; ++i) scr[(2 * i + (lane >> 5)) * 33 + (lane & 31)] = wv[i];
    }
    asm volatile("s_waitcnt lgkmcnt(0)" ::: "memory");
    const int c = lane & 7, r0 = rowmap(mode, n0);
#pragma unroll
    for (int jj = 0; jj < 4; ++jj) { const int n = (lane >> 3) + 8 * jj; const LAS float* s = scr + (8 * c) * 33 + n;
        u32x4 o; o.x = pk2(s[0 * 33], s[1 * 33]); o.y = pk2(s[2 * 33], s[3 * 33]); o.z = pk2(s[4 * 33], s[5 * 33]); o.w = pk2(s[6 * 33], s[7 * 33]);
        __builtin_nontemporal_store(o, (u32x4*)(WT + (size_t)(r0 + n) * K + k0 + 8 * c)); }
    if (sh) {
        LAS float* s2 = scr + 64 * 33;
#pragma unroll
        for (int g = 0; g < 3; ++g) s2[g * 64 + lane] = sh[(size_t)g * NMOD + k0 + lane];
        asm volatile("s_waitcnt lgkmcnt(0)" ::: "memory");
        const int n = lane & 31, hf = lane >> 5;
        float a0 = 0.f, a1 = 0.f, a2 = 0.f;
#pragma unroll 8
        for (int kk = 0; kk < 32; ++kk) { const int k = hf * 32 + kk; const float w = scr[k * 33 + n]; a0 += w * s2[k]; a1 += w * s2[64 + k]; a2 += w * s2[128 + k]; }
        a0 += __shfl_xor(a0, 32); a1 += __shfl_xor(a1, 32); a2 += __shfl_xor(a2, 32);
        if (lane < 32) {
            __hip_atomic_fetch_add(shw + r0 + n, a0, __ATOMIC_RELAXED, __HIP_MEMORY_SCOPE_AGENT);
            __hip_atomic_fetch_add(shw + 5632 + r0 + n, a1, __ATOMIC_RELAXED, __HIP_MEMORY_SCOPE_AGENT);
            __hip_atomic_fetch_add(shw + 2 * 5632 + r0 + n, a2, __ATOMIC_RELAXED, __HIP_MEMORY_SCOPE_AGENT);
        }
    }
    asm volatile("s_waitcnt lgkmcnt(0)" ::: "memory");
}

constexpr int I_WIN = 16 * 176, I_WOUT = 44 * 32, I_DQKV = 16 * 96, I_WO = 16 * 32, I_MDOWN = 16 * 33, I_MQUP = 12 * 48, I_MKVUP = 4 * 64;
__device__ __forceinline__ int layer_items(int L) { return 2 * I_WIN + 2 * I_WOUT + ((L & 1) ? I_MDOWN + I_MQUP + I_MKVUP + I_WO : I_DQKV + I_WO); }
__device__ __forceinline__ void xpose_layer_item(int L, int r, LAS float* scr, int lane) {
    unsigned char* ws = ARGS.ws;
    const float* mod = (const float*)(ws + OFF_MOD); float* SHW = (float*)(ws + OFF_SHW);
    const int j = L >> 1;
    const float* shm = mod + (size_t)L * 3 * NMOD;
    if (r < 2 * I_WIN) { const int f = r / I_WIN, w = 2 * L + f, wh = 2 * f;
        xpose_item(ARGS.ffn_w_in + (size_t)w * DM * 2 * DFF, DM, 2 * DFF, (bf16*)(ws + OFF_WIN + w * SZ_WIN), 1, scr, r - f * I_WIN, lane, shm + (size_t)(3 * wh) * 1024, SHW + (size_t)(L * 3 + wh) * 3 * 5632); return; }
    r -= 2 * I_WIN;
    if (r < 2 * I_WOUT) { const int f = r / I_WOUT, w = 2 * L + f; xpose_item(ARGS.ffn_w_out + (size_t)w * DFF * DM, DFF, DM, (bf16*)(ws + OFF_WOUT + w * SZ_WOUT), 0, scr, r - f * I_WOUT, lane); return; }
    r -= 2 * I_WOUT;
    if ((L & 1) == 0) {
        if (r < I_DQKV) { xpose_item(ARGS.diff_w_qkv + (size_t)j * DM * 3072, DM, 3072, (bf16*)(ws + OFF_DQKV + j * SZ_DQKV), 2, scr, r, lane, shm + 3 * 1024, SHW + (size_t)(L * 3 + 1) * 3 * 5632); return; }
        r -= I_DQKV;
        xpose_item(ARGS.diff_w_o + (size_t)j * DM * DM, DM, DM, (bf16*)(ws + OFF_DWO + j * SZ_WO), 0, scr, r, lane);
    } else {
        if (r < I_MDOWN) { xpose_item(ARGS.mla_w_down + (size_t)j * DM * 1056, DM, 1056, (bf16*)(ws + OFF_MDOWN + j * SZ_MDOWN), 0, scr, r, lane, shm + 3 * 1024, SHW + (size_t)(L * 3 + 1) * 3 * 5632); return; }
        r -= I_MDOWN;
        if (r < I_MQUP) { xpose_item(ARGS.mla_w_q_up + (size_t)j * 768 * 1536, 768, 1536, (bf16*)(ws + OFF_MQUP + j * SZ_MQUP), 0, scr, r, lane); return; }
        r -= I_MQUP;
        if (r < I_MKVUP) { xpose_item(ARGS.mla_w_kv_up + (size_t)j * 256 * 2048, 256, 2048, (bf16*)(ws + OFF_MKVUP + j * SZ_MKVUP), 2, scr, r, lane); return; }
        r -= I_MKVUP;
        xpose_item(ARGS.mla_w_o + (size_t)j * DM * DM, DM, DM, (bf16*)(ws + OFF_MWO + j * SZ_WO), 0, scr, r, lane);
    }
}
constexpr int Q0_ITEMS = I_WOUT + I_DQKV + I_WO + I_WIN + I_WOUT;
constexpr int QUOTA_FFN_IN = 3456, QUOTA_FFN_OUT = 4608, QUOTA_OUT_PROJ = 2304, IDLE_FFN_IN = 880 - 768, IDLE_160 = 160;
__device__ __forceinline__ bool defer_ok() { return gridDim.x == 256; }
__device__ __forceinline__ void deferred_slot(LAS unsigned char* lds, int qpos, int quota, int idle0) {
    const int tid = opaque_tid(), lane = tid & 63, wave = __builtin_amdgcn_readfirstlane(tid >> 6);
    const int qtot = Q0_ITEMS + layer_items(1) + layer_items(2) + layer_items(3);
    const int qend = qpos + quota < qtot ? qpos + quota : qtot;
    const int nw = ((int)gridDim.x - idle0) * NWAVES, w = ((int)blockIdx.x - idle0) * NWAVES + wave;
    LAS float* scr = (LAS float*)(lds + wave * 16384);
    for (int q = qpos + w; q < qend; q += nw) {
        int L, r;
        if (q < Q0_ITEMS) { L = 0;
            if (q < I_WOUT) r = 2 * I_WIN + q;
            else if (q < I_WOUT + I_DQKV) r = 2 * I_WIN + 2 * I_WOUT + (q - I_WOUT);
            else if (q < I_WOUT + I_DQKV + I_WO) r = 2 * I_WIN + 2 * I_WOUT + I_DQKV + (q - I_WOUT - I_DQKV);
            else if (q < I_WOUT + I_DQKV + I_WO + I_WIN) r = I_WIN + (q - I_WOUT - I_DQKV - I_WO);
            else r = 2 * I_WIN + I_WOUT + (q - I_WOUT - I_DQKV - I_WO - I_WIN);
        } else { int qq = q - Q0_ITEMS; L = 1; if (qq >= layer_items(1)) { qq -= layer_items(1); L = 2; if (qq >= layer_items(2)) { qq -= layer_items(2); L = 3; } } r = qq; }
        xpose_layer_item(L, r, scr, lane);
    }
}

__device__ __forceinline__ void prologue(LAS unsigned char* lds, const int part) {
    const int tid = opaque_tid(), lane = tid & 63, wave = __builtin_amdgcn_readfirstlane(tid >> 6);
    unsigned char* ws = ARGS.ws;
    const int G = gridDim.x, bx = blockIdx.x;
    if (part == 0) {
        LAS float* sil = (LAS float*)lds;
        LAS float* red = (LAS float*)(lds + 12288);
        for (int i = tid; i < 3 * 1024; i += NTHREADS) { const int g = i >> 10, k = i & 1023; const float cv = g == 0 ? ARGS.c_ctx[k] : ARGS.c[(g - 1) * 1024 + k]; sil[i] = cv / (1.f + __expf(-cv)); }
        __syncthreads();
        float* mod = (float*)(ws + OFF_MOD);
        const int ln = lane < 36 ? lane : 35;
        for (int u = bx; u < 4 * 64; u += G) {
            const int l = u >> 6, n0 = (u & 63) * 144;
            const float* wp = ARGS.w_mod + ((size_t)l * 1024 + wave * 128) * NMOD + n0 + 4 * ln;
            f32x4 acc[3] = {{0.f, 0.f, 0.f, 0.f}, {0.f, 0.f, 0.f, 0.f}, {0.f, 0.f, 0.f, 0.f}};
#pragma unroll 1
            for (int kb = 0; kb < 128; kb += 16) {
                f32x4 w[16];
#pragma unroll
                for (int kk = 0; kk < 16; ++kk) w[kk] = *(const f32x4*)(wp + (size_t)(kb + kk) * NMOD);
#pragma unroll
                for (int kk = 0; kk < 16; ++kk) { const int k = wave * 128 + kb + kk;
#pragma unroll
                    for (int g = 0; g < 3; ++g) acc[g] += w[kk] * sil[g * 1024 + k]; }
            }
            if (lane < 36) {
#pragma unroll
                for (int g = 0; g < 3; ++g) *(LAS f32x4*)(red + (wave * 3 + g) * 144 + 4 * lane) = acc[g]; }
            __syncthreads();
            if (tid < 432) { const int g = tid / 144, cidx = tid - g * 144; float s = ARGS.b_mod[(size_t)l * NMOD + n0 + cidx];
#pragma unroll
                for (int w8 = 0; w8 < 8; ++w8) s += red[(w8 * 3 + g) * 144 + cidx];
                mod[((size_t)l * 3 + g) * NMOD + n0 + cidx] = s; }
            __syncthreads();
        }
    }
    if (part == 1) {
        LAS float* scr = (LAS float*)(lds + wave * 16384);
        const int gw = bx * NWAVES + wave, NGW = G * NWAVES;
        if (defer_ok()) { for (int r = gw; r < I_WIN; r += NGW) xpose_layer_item(0, r, scr, lane); }
        else for (int L = 0; L < 4; ++L) { const int n = layer_items(L);
            for (int r = gw; r < n; r += NGW) xpose_layer_item(L, r, scr, lane); }
    }
    if (part == 0) {
        const size_t gt = (size_t)bx * NTHREADS + tid, NT = (size_t)G * NTHREADS;
        for (size_t i = gt; i < (size_t)2 * 2 * 256 * 128; i += NT) {
            const int c8 = (int)(i & 127), s = (int)((i >> 7) & 255), j = (int)((i >> 15) & 1), b = (int)(i >> 16);
            const size_t src = (((size_t)(b * 2 + j) * 256 + s) * 1024) + c8 * 8, dst = (((size_t)j * 512 + b * 256 + s) * 1024) + c8 * 8;
            { const f32x4 a = *(const f32x4*)(ARGS.cache_diff_k + src), bb = *(const f32x4*)(ARGS.cache_diff_k + src + 4); float v[8] = {a.x, a.y, a.z, a.w, bb.x, bb.y, bb.z, bb.w}; *(u32x4*)((bf16*)(ws + OFF_KC) + dst) = pack8(v); }
            { const f32x4 a = *(const f32x4*)(ARGS.cache_diff_v + src), bb = *(const f32x4*)(ARGS.cache_diff_v + src + 4); float v[8] = {a.x, a.y, a.z, a.w, bb.x, bb.y, bb.z, bb.w}; *(u32x4*)((bf16*)(ws + OFF_VC) + dst) = pack8(v); }
        }
        for (size_t i = gt; i < (size_t)2 * 2 * 256 * 32; i += NT) {
            const int c8 = (int)(i & 31), s = (int)((i >> 5) & 255), j = (int)((i >> 13) & 1), b = (int)(i >> 14);
            const size_t src = (((size_t)(b * 2 + j) * 256 + s) * 256) + c8 * 8;
            const f32x4 a = *(const f32x4*)(ARGS.cache_mla_ckv + src), bb = *(const f32x4*)(ARGS.cache_mla_ckv + src + 4); float v[8] = {a.x, a.y, a.z, a.w, bb.x, bb.y, bb.z, bb.w};
            *(u32x4*)((bf16*)(ws + OFF_CKV + j * SZ_CKV) + ((size_t)(NTOK + b * 256 + s) * 256) + c8 * 8) = pack8(v);
        }
        for (size_t i = gt; i < (size_t)2 * 2 * 256; i += NT) {
            const int s = (int)(i & 255), j = (int)((i >> 8) & 1), b = (int)(i >> 9);
            const float* src = ARGS.cache_mla_kpe + ((size_t)(b * 2 + j) * 256 + s) * 32;
            float* dst = (float*)(ws + OFF_KPE + j * SZ_KPE) + (size_t)(NTOK + b * 256 + s) * 32;
            float ss = 0.f;
            for (int e = 0; e < 32; ++e) { const float v = src[e]; dst[e] = v * ARGS.mla_k_norm[j * 96 + 64 + e]; ss += v * v; }
            ((float*)(ws + OFF_KPSS + j * SZ_KPSS))[NTOK + b * 256 + s] = ss;
        }
        for (size_t i = gt; i < (size_t)2 * 224 * 128; i += NT) {
            const int c8 = (int)(i & 127), r = (int)((i >> 7) % 224), w = (int)(i / (224 * 128));
            *(u32x4*)((bf16*)(ws + OFF_MDOWN + w * SZ_MDOWN) + (size_t)(1056 + r) * 1024 + c8 * 8) = (u32x4){0u, 0u, 0u, 0u};
        }
        for (size_t i = gt; i < (size_t)12 * 3 * 5632 / 4; i += NT) *(f32x4*)((float*)(ws + OFF_SHW) + 4 * i) = (f32x4){0.f, 0.f, 0.f, 0.f};
        for (size_t i = gt; i < (size_t)12 * NTOK / 4; i += NT) *(f32x4*)((float*)(ws + OFF_SS) + 4 * i) = (f32x4){0.f, 0.f, 0.f, 0.f};
        for (size_t i = gt; i < 64 * 16 + 64 * 8; i += NT) {
            const bool isD = i < 64 * 16; const int idx = isD ? (int)i : (int)i - 64 * 16;
            const int pos = isD ? idx >> 4 : idx >> 3, f = isD ? idx & 15 : idx & 7;
            const float freq = __builtin_amdgcn_exp2f(-(isD ? (float)f / 16.f : (float)f / 8.f) * 13.287712379549449f);
            float rev = (float)pos * freq * 0.15915494309189535f; rev -= floorf(rev);
            const float cs = __builtin_amdgcn_cosf(rev), sn = __builtin_amdgcn_sinf(rev);
            float* tb = isD ? (float*)(ws + OFF_TABD) : (float*)(ws + OFF_TABM);
            tb[2 * idx] = cs; tb[2 * idx + 1] = sn;
        }
    }

    if (part == 1) {
        const float* mod = (const float*)(ws + OFF_MOD);
        const float* g = ARGS.norm_g; bf16* H = (bf16*)(ws + OFF_H); float* SS = (float*)(ws + OFF_SS);
        const int gw = bx * NWAVES + wave, NGW = G * NWAVES;
        constexpr int RB = 5;
        for (int row0 = gw; row0 < NTOK; row0 += RB * NGW) {
            f32x4 v[RB][4];
#pragma unroll
            for (int r = 0; r < RB; ++r) { const int row = row0 + r * NGW < NTOK ? row0 + r * NGW : gw;
                const float* xr = row < NCTX ? ARGS.x_prompt + (size_t)row * DM : ARGS.x_sample + (size_t)(row - NCTX) * DM;
#pragma unroll
                for (int jj = 0; jj < 4; ++jj) v[r][jj] = *(const f32x4*)(xr + 4 * lane + 256 * jj); }
#pragma unroll
            for (int r = 0; r < RB; ++r) { const int row = row0 + r * NGW;
                if (row < NTOK) {
                    const float* md = mod + (size_t)tok_group(row) * NMOD + 1024;
                    float ss = 0.f;
#pragma unroll
                    for (int jj = 0; jj < 4; ++jj) { const int c = 4 * lane + 256 * jj; const f32x4 x4 = v[r][jj], gg = *(const f32x4*)(g + c), sc = *(const f32x4*)(md + c);
                        ss += x4.x * x4.x + x4.y * x4.y + x4.z * x4.z + x4.w * x4.w;
                        *(u32x2*)(H + (size_t)row * DM + c) = (u32x2){pk2(x4.x * gg.x * (1.f + sc.x), x4.y * gg.y * (1.f + sc.y)), pk2(x4.z * gg.z * (1.f + sc.z), x4.w * gg.w * (1.f + sc.w))}; }
                    ss = wave_sum(ss);
                    if (lane == 0) SS[row] = ss;
                }
            }
        }
    }
}

__device__ __forceinline__ void init_phase(LAS unsigned char* lds) {
    const int tid = opaque_tid(), lane = tid & 63, wave = __builtin_amdgcn_readfirstlane(tid >> 6);
    unsigned char* ws = ARGS.ws;
    const float* mod = (const float*)(ws + OFF_MOD);
    const int gw = blockIdx.x * NWAVES + wave, NGW = gridDim.x * NWAVES;
    {
        const float* g = ARGS.norm_g; bf16* H = (bf16*)(ws + OFF_H); float* SS = (float*)(ws + OFF_SS);
        for (int row = gw; row < NTOK; row += NGW) {
            const float* xr = row < NCTX ? ARGS.x_prompt + (size_t)row * DM : ARGS.x_sample + (size_t)(row - NCTX) * DM;
            const float* md = mod + (size_t)tok_group(row) * NMOD + 1024;
            float ss = 0.f;
#pragma unroll
            for (int jj = 0; jj < 4; ++jj) { const int c = 4 * lane + 256 * jj; const f32x4 v = *(const f32x4*)(xr + c), gg = *(const f32x4*)(g + c), sc = *(const f32x4*)(md + c);
                ss += v.x * v.x + v.y * v.y + v.z * v.z + v.w * v.w;
                *(u32x2*)(H + (size_t)row * DM + c) = (u32x2){pk2(v.x * gg.x * (1.f + sc.x), v.y * gg.y * (1.f + sc.y)), pk2(v.z * gg.z * (1.f + sc.z), v.w * gg.w * (1.f + sc.w))}; }
            ss = wave_sum(ss);
            if (lane == 0) SS[row] = ss;
        }
    }
    {
        float* SHW = (float*)(ws + OFF_SHW);
        for (int l = 0; l < 4; ++l) {
            const int j = l >> 1, NM = (l & 1) ? 1280 : 3072, tot = 2 * 5632 + NM;
            for (int r = gw; r < tot; r += NGW) {
                int which, n; const bf16* Bt;
                if (r < 5632) { which = 0; n = r; Bt = (const bf16*)(ws + OFF_WIN + (size_t)(l * 2) * SZ_WIN); }
                else if (r < 2 * 5632) { which = 2; n = r - 5632; Bt = (const bf16*)(ws + OFF_WIN + (size_t)(l * 2 + 1) * SZ_WIN); }
                else { which = 1; n = r - 2 * 5632; Bt = (l & 1) ? (const bf16*)(ws + OFF_MDOWN + j * SZ_MDOWN) : (const bf16*)(ws + OFF_DQKV + j * SZ_DQKV); }
                const bf16* wr_ = Bt + (size_t)n * DM;
                const bf16x8 w0 = *(const bf16x8*)(wr_ + 8 * lane), w1 = *(const bf16x8*)(wr_ + 512 + 8 * lane);
                const float* sh = mod + (size_t)l * 3 * NMOD + (size_t)(3 * which) * 1024;
                float a[3];
#pragma unroll
                for (int g = 0; g < 3; ++g) { const float* s = sh + (size_t)g * NMOD; float acc = 0.f;
                    const f32x4 s0 = *(const f32x4*)(s + 8 * lane), s1 = *(const f32x4*)(s + 8 * lane + 4), s2 = *(const f32x4*)(s + 512 + 8 * lane), s3 = *(const f32x4*)(s + 512 + 8 * lane + 4);
                    acc += bf2f((unsigned short)w0[0]) * s0.x + bf2f((unsigned short)w0[1]) * s0.y + bf2f((unsigned short)w0[2]) * s0.z + bf2f((unsigned short)w0[3]) * s0.w;
                    acc += bf2f((unsigned short)w0[4]) * s1.x + bf2f((unsigned short)w0[5]) * s1.y + bf2f((unsigned short)w0[6]) * s1.z + bf2f((unsigned short)w0[7]) * s1.w;
                    acc += bf2f((unsigned short)w1[0]) * s2.x + bf2f((unsigned short)w1[1]) * s2.y + bf2f((unsigned short)w1[2]) * s2.z + bf2f((unsigned short)w1[3]) * s2.w;
                    acc += bf2f((unsigned short)w1[4]) * s3.x + bf2f((unsigned short)w1[5]) * s3.y + bf2f((unsigned short)w1[6]) * s3.z + bf2f((unsigned short)w1[7]) * s3.w;
                    a[g] = wave_sum(acc); }
                if (lane < 3) SHW[((size_t)(l * 3 + which) * 3 + lane) * 5632 + n] = lane == 0 ? a[0] : (lane == 1 ? a[1] : a[2]);
            }
        }
    }
}
__device__ __forceinline__ void mla_norm_phase(int j) {
    const int tid = opaque_tid(), lane = tid & 63, wave = __builtin_amdgcn_readfirstlane(tid >> 6);
    unsigned char* ws = ARGS.ws;
    const float* DOWN = (const float*)(ws + OFF_DOWN); bf16* CQ = (bf16*)(ws + OFF_CQ); bf16* CKV = (bf16*)(ws + OFF_CKV + j * SZ_CKV);
    float* KPE = (float*)(ws + OFF_KPE + j * SZ_KPE); float* KPSS = (float*)(ws + OFF_KPSS + j * SZ_KPSS);
    const float* qag = ARGS.mla_q_a_norm + j * 768; const float* kvag = ARGS.mla_kv_a_norm + j * 256;
    const int gw = blockIdx.x * NWAVES + wave, NGW = gridDim.x * NWAVES;
    const f32x4 kg4 = *(const f32x4*)(kvag + 4 * lane);
    const float kpg = lane < 32 ? ARGS.mla_k_norm[j * 96 + 64 + lane] : 0.f;
    f32x4 qg4[3];
#pragma unroll
    for (int jj = 0; jj < 3; ++jj) qg4[jj] = *(const f32x4*)(qag + 4 * lane + 256 * jj);
    constexpr int RB = 5;
    for (int row0 = gw; row0 < NTOK; row0 += RB * NGW) {
        f32x4 v[RB][3], kv[RB]; float pe[RB];
#pragma unroll
        for (int r = 0; r < RB; ++r) { const int row = row0 + r * NGW; const float* dr = DOWN + (size_t)(row < NTOK ? row : gw) * 1056;
#pragma unroll
            for (int jj = 0; jj < 3; ++jj) v[r][jj] = *(const f32x4*)(dr + 4 * lane + 256 * jj);
            kv[r] = *(const f32x4*)(dr + 768 + 4 * lane);
            pe[r] = lane < 32 ? dr[1024 + lane] : 0.f; }
#pragma unroll
        for (int r = 0; r < RB; ++r) { const int row = row0 + r * NGW;
            if (row < NTOK) {
                float ss = 0.f;
#pragma unroll
                for (int jj = 0; jj < 3; ++jj) ss += v[r][jj].x * v[r][jj].x + v[r][jj].y * v[r][jj].y + v[r][jj].z * v[r][jj].z + v[r][jj].w * v[r][jj].w;
                const float rq = __builtin_amdgcn_rsqf(wave_sum(ss) * (1.f / 768.f) + EPS);
#pragma unroll
                for (int jj = 0; jj < 3; ++jj) { const int c = 4 * lane + 256 * jj; const f32x4 gg = qg4[jj];
                    *(u32x2*)(CQ + (size_t)row * 768 + c) = (u32x2){pk2(v[r][jj].x * rq * gg.x, v[r][jj].y * rq * gg.y), pk2(v[r][jj].z * rq * gg.z, v[r][jj].w * rq * gg.w)}; }
                const f32x4 k4 = kv[r];
                const float rk = __builtin_amdgcn_rsqf(wave_sum(k4.x * k4.x + k4.y * k4.y + k4.z * k4.z + k4.w * k4.w) * (1.f / 256.f) + EPS);
                const f32x4 kn = (f32x4){k4.x * rk * kg4.x, k4.y * rk * kg4.y, k4.z * rk * kg4.z, k4.w * rk * kg4.w};
                *(u32x2*)(CKV + (size_t)row * 256 + 4 * lane) = (u32x2){pk2(kn.x, kn.y), pk2(kn.z, kn.w)};
                const float pss = wave_sum(pe[r] * pe[r]);
                if (lane < 32) KPE[(size_t)row * 32 + lane] = pe[r] * kpg;
                if (lane == 0) KPSS[row] = pss;
                if (row < NCTX) { const int b = row >> 8, s = row & 255;
                    *(f32x4*)(ARGS.out + OUT_CKV + ((size_t)(b * 2 + j) * 256 + s) * 256 + 4 * lane) = kn;
                    if (lane < 32) ARGS.out[OUT_KPE + ((size_t)(b * 2 + j) * 256 + s) * 32 + lane] = pe[r]; }
            }
        }
    }
}

struct AttnArgs {
    const bf16* Q; int qpitch;
    const bf16* K; int kpitch;
    const bf16* V; int vpitch;
    const bf16* Kc; const bf16* Vc;
    bf16* O;
    const float* qg;
    const float* tabM;
    const float* subln;
    float lam, one_m_lam_init, scale_log2;
    unsigned* ctr;
    int nheads;
};

template <int NC, int DK, int DV, bool MLA, int QT>
__device__ __forceinline__ void attn_phase(LAS unsigned char* lds, const AttnArgs& a) {
    const int tid = opaque_tid(), lane = tid & 63, wave = __builtin_amdgcn_readfirstlane(tid >> 6);
    constexpr int KB = NC * DK * 2, VB = DV * 2;
    constexpr int KP = 272, VP = VB + 32;
    constexpr bool VSWZ = (VB / 16 == 16);
    constexpr int KPR = KB / 16, VPR = VB / 16, NPIECE = 64 * (KPR + VPR), NST = (NPIECE + NTHREADS - 1) / NTHREADS;
    constexpr int KS = DK / 32, DC = DV / 16;
    LAS unsigned char* ldsK = lds; LAS unsigned char* ldsV = lds + 64 * KP;
    volatile LAS int* uslot = (volatile LAS int*)(lds + 64 * KP + 64 * VP);
    const int fr = lane & 15, g = lane >> 4;
    constexpr int LQB = 8 / QT, CQB = 2 / QT;
    const int nlat = 2 * a.nheads * LQB, nctx = 32 * a.nheads * CQB, nunits = nlat + nctx;
    const bool stat = (gridDim.x == 256) && nlat == 128 && nctx == 512;
    for (int it = 0;; ++it) {
        int u;
        if (stat) { const int bxs = (int)blockIdx.x; u = bxs < 128 ? (it == 0 ? bxs : nunits) : (it < 4 ? 128 + 4 * (bxs - 128) + it : nunits); }
        else {
            __syncthreads();
            if (tid == 0) *uslot = (int)atomicAdd(a.ctr, 1u);
            __syncthreads();
            u = *uslot;
        }
        if (u >= nunits) break;
        int b, h, qb, nch, qrow0; const bf16 *kc0, *vc0, *kn0, *vn0; bool lat;
        if (u < nlat) { lat = true; b = u / (a.nheads * LQB); const int r = u % (a.nheads * LQB); h = r / LQB; qb = r % LQB; nch = 20; qrow0 = NCTX + b * 1024 + qb * 128 * QT;
            kc0 = a.Kc + (size_t)(b * 256) * a.kpitch; vc0 = a.Vc + (size_t)(b * 256) * a.vpitch; kn0 = a.K + (size_t)(NCTX + b * 1024) * a.kpitch; vn0 = a.V + (size_t)(NCTX + b * 1024) * a.vpitch; }
        else { lat = false; const int uu = u - nlat; b = uu / (a.nheads * CQB); const int r = uu % (a.nheads * CQB); h = r / CQB; qb = r % CQB; nch = 4; qrow0 = b * 256 + qb * 128 * QT;
            kc0 = a.K + (size_t)(b * 256) * a.kpitch; vc0 = a.V + (size_t)(b * 256) * a.vpitch; kn0 = kc0; vn0 = vc0; }
        bf16x8 qf[QT][NC][KS];
#pragma unroll
        for (int qt = 0; qt < QT; ++qt) {
        const int qrow = qrow0 + wave * 16 * QT + qt * 16 + fr;
        if constexpr (!MLA) {
#pragma unroll
            for (int c = 0; c < NC; ++c)
#pragma unroll
                for (int ks = 0; ks < KS; ++ks) qf[qt][c][ks] = *(const bf16x8*)(a.Q + (size_t)qrow * a.qpitch + (h * NC + c) * DK + 32 * ks + 8 * g);
        } else {
            float x[KS][8]; float ss = 0.f;
#pragma unroll
            for (int ks = 0; ks < KS; ++ks) { const bf16x8 raw = *(const bf16x8*)(a.Q + (size_t)qrow * a.qpitch + h * DK + 32 * ks + 8 * g);
#pragma unroll
                for (int i = 0; i < 8; ++i) { x[ks][i] = bf2f((unsigned short)raw[i]); ss += x[ks][i] * x[ks][i]; } }
            ss = quad_sum(ss);
            const float rstd = __builtin_amdgcn_rsqf(ss * (1.f / DK) + EPS);
#pragma unroll
            for (int ks = 0; ks < KS; ++ks)
#pragma unroll
                for (int i = 0; i < 8; ++i) x[ks][i] = x[ks][i] * rstd * a.qg[32 * ks + 8 * g + i];
            if (lat) {
                const int t = (qrow - NCTX) & 1023, pos = (g >> 1) ? (t & 63) : (t >> 6);
                const float* tb = a.tabM + (size_t)pos * 16;
#pragma unroll
                for (int i = 0; i < 8; ++i) { const float p = __shfl_xor(x[KS - 1][i], 16), cs = tb[2 * i], sn = tb[2 * i + 1];
                    x[KS - 1][i] = (g & 1) == 0 ? x[KS - 1][i] * cs - p * sn : x[KS - 1][i] * cs + p * sn; }
            }
#pragma unroll
            for (int ks = 0; ks < KS; ++ks) qf[qt][0][ks] = __builtin_bit_cast(bf16x8, pack8(x[ks]));
        }
        }
        float mrun[QT][NC], lrun[QT][NC]; f32x4 o[QT][NC][DC];
#pragma unroll
        for (int qt = 0; qt < QT; ++qt)
#pragma unroll
        for (int c = 0; c < NC; ++c) { mrun[qt][c] = -1e30f; lrun[qt][c] = 0.f;
#pragma unroll
            for (int dc = 0; dc < DC; ++dc) o[qt][c][dc] = (f32x4){0.f, 0.f, 0.f, 0.f}; }
        constexpr int NKP = 64 * KPR, NVP = 64 * VPR, NKL = (NKP + NTHREADS - 1) / NTHREADS, NVL = NVP / NTHREADS;
        static_assert(NVP % NTHREADS == 0 && NKL * NTHREADS <= 2 * NKP, "staging piece map");
        constexpr int DEPTH = MLA ? 4 : 2;
        u32x4 st[DEPTH][NKL + NVL];
        const int kcol = h * NC * DK, vcol = h * DV;
#define ATT_PREFETCH(ch, SB) do { const int key0 = (ch) * 64; const bf16* kb_ = key0 < 256 ? kc0 + (size_t)key0 * a.kpitch : kn0 + (size_t)(key0 - 256) * a.kpitch; \
            const bf16* vb_ = key0 < 256 ? vc0 + (size_t)key0 * a.vpitch : vn0 + (size_t)(key0 - 256) * a.vpitch; \
            _Pragma("unroll") for (int s_ = 0; s_ < NKL; ++s_) { const int p0_ = tid + s_ * NTHREADS, p_ = p0_ < NKP ? p0_ : p0_ - NKP; const int r_ = p_ / KPR, c_ = p_ % KPR; \
                st[SB][s_] = *(const u32x4*)(kb_ + (size_t)r_ * a.kpitch + kcol + c_ * 8); } \
            _Pragma("unroll") for (int s_ = 0; s_ < NVL; ++s_) { const int q_ = tid + s_ * NTHREADS, r_ = q_ / VPR, c_ = q_ % VPR; \
                st[SB][NKL + s_] = *(const u32x4*)(vb_ + (size_t)r_ * a.vpitch + vcol + c_ * 8); } } while (0)
#define ATT_COMMIT(SB) do { \
            _Pragma("unroll") for (int s_ = 0; s_ < NKL; ++s_) { const int p0_ = tid + s_ * NTHREADS, p_ = p0_ < NKP ? p0_ : p0_ - NKP; const int r_ = p_ / KPR, c_ = p_ % KPR; \
                *(LAS u32x4*)(ldsK + r_ * KP + (c_ ^ (((r_ >> 4) & 1) << 2)) * 16) = st[SB][s_]; } \
            _Pragma("unroll") for (int s_ = 0; s_ < NVL; ++s_) { const int q_ = tid + s_ * NTHREADS, r_ = q_ / VPR, c_ = q_ % VPR; \
                *(LAS u32x4*)(ldsV + r_ * VP + (VSWZ ? (c_ ^ (((r_ >> 3) & 1) << 3)) : c_) * 16) = st[SB][NKL + s_]; } } while (0)
#pragma unroll
        for (int hb = 0; hb < DEPTH; ++hb) ATT_PREFETCH(hb, hb);
        for (int ch2 = 0; ch2 < nch; ch2 += DEPTH) {
#pragma unroll
          for (int hb = 0; hb < DEPTH; ++hb) {
            const int ch = ch2 + hb;
            __syncthreads();
            ATT_COMMIT(hb);
            __syncthreads();
            { const int chp = ch + DEPTH < nch ? ch + DEPTH : nch - 1;
              ATT_PREFETCH(chp, hb); }
            bf16x8 pb[QT][NC][2];
#pragma unroll
            for (int c = 0; c < NC; ++c) {
                f32x4 sq[QT][4];
#pragma unroll
                for (int kt = 0; kt < 4; ++kt) {
#pragma unroll
                    for (int qt = 0; qt < QT; ++qt) sq[qt][kt] = (f32x4){0.f, 0.f, 0.f, 0.f};
                    const int keyrow = 32 * (kt >> 1) + 8 * (fr >> 2) + 4 * (kt & 1) + (fr & 3);
#pragma unroll
                    for (int ks = 0; ks < KS; ++ks) { const bf16x8 kf = *(const LAS bf16x8*)(ldsK + keyrow * KP + (((c * DK * 2 + ks * 64) / 16 + g) ^ (((fr >> 3) & 1) << 2)) * 16);
#pragma unroll
                        for (int qt = 0; qt < QT; ++qt) sq[qt][kt] = __builtin_amdgcn_mfma_f32_16x16x32_bf16(kf, qf[qt][c][ks], sq[qt][kt], 0, 0, 0); }
                }
#pragma unroll
                for (int qt = 0; qt < QT; ++qt) {
                f32x4 (&s)[4] = sq[qt];
                float mx = -1e30f;
#pragma unroll
                for (int kt = 0; kt < 4; ++kt) mx = fmaxf(mx, fmaxf(fmaxf(s[kt].x, s[kt].y), fmaxf(s[kt].z, s[kt].w)));
                mx = quad_max(mx) * a.scale_log2;
                const bool need = mx > mrun[qt][c] + 8.f;
                if (__builtin_amdgcn_ballot_w64(need) != 0ull) {
                    const float mnew = need ? mx : mrun[qt][c], alpha = __builtin_amdgcn_exp2f(mrun[qt][c] - mnew);
                    lrun[qt][c] *= alpha; mrun[qt][c] = mnew;
#pragma unroll
                    for (int dc = 0; dc < DC; ++dc) o[qt][c][dc] = o[qt][c][dc] * alpha;
                }
                const float nm = -mrun[qt][c], sc2 = a.scale_log2;
                float rs = 0.f;
#pragma unroll
                for (int kt = 0; kt < 4; ++kt) { s[kt].x = __builtin_amdgcn_exp2f(__builtin_fmaf(s[kt].x, sc2, nm)); s[kt].y = __builtin_amdgcn_exp2f(__builtin_fmaf(s[kt].y, sc2, nm));
                    s[kt].z = __builtin_amdgcn_exp2f(__builtin_fmaf(s[kt].z, sc2, nm)); s[kt].w = __builtin_amdgcn_exp2f(__builtin_fmaf(s[kt].w, sc2, nm));
                    rs += (s[kt].x + s[kt].y) + (s[kt].z + s[kt].w); }
                rs = quad_sum(rs);
                lrun[qt][c] += rs;
#pragma unroll
                for (int t = 0; t < 2; ++t) { u32x4 w; w.x = pk2(s[2 * t].x, s[2 * t].y); w.y = pk2(s[2 * t].z, s[2 * t].w); w.z = pk2(s[2 * t + 1].x, s[2 * t + 1].y); w.w = pk2(s[2 * t + 1].z, s[2 * t + 1].w);
                    pb[qt][c][t] = __builtin_bit_cast(bf16x8, w); }
                }
            }
#pragma unroll
            for (int t = 0; t < 2; ++t) { __builtin_amdgcn_sched_barrier(0);
#pragma unroll
                for (int dc = 0; dc < DC; ++dc) {
                    const int vslot = 2 * dc + ((fr & 3) >> 1);
                    const LAS unsigned char* vp = ldsV + (32 * t + 8 * g + (fr >> 2)) * VP + (VSWZ ? (vslot ^ ((g & 1) << 3)) : vslot) * 16 + (fr & 1) * 8;
                    const s16x4 lo = __builtin_bit_cast(s16x4, __builtin_amdgcn_ds_read_tr16_b64_v4i16((LAS s16x4*)vp));
                    const s16x4 hi = __builtin_bit_cast(s16x4, __builtin_amdgcn_ds_read_tr16_b64_v4i16((LAS s16x4*)(vp + 4 * VP)));
                    bf16x8 vf; vf[0] = lo[0]; vf[1] = lo[1]; vf[2] = lo[2]; vf[3] = lo[3]; vf[4] = hi[0]; vf[5] = hi[1]; vf[6] = hi[2]; vf[7] = hi[3];
#pragma unroll
                    for (int qt = 0; qt < QT; ++qt)
#pragma unroll
                    for (int c = 0; c < NC; ++c) o[qt][c][dc] = __builtin_amdgcn_mfma_f32_16x16x32_bf16(vf, pb[qt][c][t], o[qt][c][dc], 0, 0, 0);
                } }
          }
        }
#undef ATT_PREFETCH
#undef ATT_COMMIT
#pragma unroll
        for (int qt = 0; qt < QT; ++qt) {
        const int qrow = qrow0 + wave * 16 * QT + qt * 16 + fr;
        bf16* orow = a.O + (size_t)qrow * 1024 + h * DV + 4 * g;
        if constexpr (!MLA) {
            const float i0 = __builtin_amdgcn_rcpf(lrun[qt][0]), i1 = a.lam * __builtin_amdgcn_rcpf(lrun[qt][NC - 1]);
            float ss = 0.f;
#pragma unroll
            for (int dc = 0; dc < DC; ++dc) { o[qt][0][dc] = o[qt][0][dc] * i0 - o[qt][NC - 1][dc] * i1; ss += o[qt][0][dc].x * o[qt][0][dc].x + o[qt][0][dc].y * o[qt][0][dc].y + o[qt][0][dc].z * o[qt][0][dc].z + o[qt][0][dc].w * o[qt][0][dc].w; }
            ss = quad_sum(ss);
            const float rstd = __builtin_amdgcn_rsqf(ss * (1.f / DV) + EPS) * a.one_m_lam_init;
#pragma unroll
            for (int dc = 0; dc < DC; ++dc) { const f32x4 sg = *(const f32x4*)(a.subln + 16 * dc + 4 * g);
                *(u32x2*)(orow + 16 * dc) = (u32x2){pk2(o[qt][0][dc].x * rstd * sg.x, o[qt][0][dc].y * rstd * sg.y), pk2(o[qt][0][dc].z * rstd * sg.z, o[qt][0][dc].w * rstd * sg.w)}; }
        } else {
            const float i0 = __builtin_amdgcn_rcpf(lrun[qt][0]);
#pragma unroll
            for (int dc = 0; dc < DC; ++dc) *(u32x2*)(orow + 16 * dc) = (u32x2){pk2(o[qt][0][dc].x * i0, o[qt][0][dc].y * i0), pk2(o[qt][0][dc].z * i0, o[qt][0][dc].w * i0)};
        }
        }
    }
}

#define XB_TMO      128
#define XB_XCNT(j)  (256  + 64 * (j))
#define XB_XSUB(j)  (1280 + 64 * (j))
#define XB_XGEN(j)  (2304 + 64 * (j))
#define XB_TOP      3328
#define XB_TOPGEN   3392
#define XCD_BAR_WORDS 3456
#define XB_SPIN_CAP (1u << 18)

__device__ __forceinline__ unsigned xb_ld(unsigned* p)              { return __hip_atomic_load(p, __ATOMIC_RELAXED, __HIP_MEMORY_SCOPE_AGENT); }
__device__ __forceinline__ unsigned xb_add(unsigned* p, unsigned v) { return __hip_atomic_fetch_add(p, v, __ATOMIC_RELAXED, __HIP_MEMORY_SCOPE_AGENT); }
__device__ __forceinline__ unsigned xb_xcc_id() { return (unsigned)__builtin_amdgcn_s_getreg((3 << 11) | 20) & 0xFu; }
#define XB_SPIN(cond, bar) do { unsigned _sp = 0; while (cond) { __builtin_amdgcn_s_sleep(1); \
    if ((++_sp & 255u) == 0u) { if (xb_ld(&(bar)[XB_TMO])) break; if (_sp > XB_SPIN_CAP) { atomicAdd(&(bar)[XB_TMO], 1u); break; } } } } while (0)

struct XcdBarrier {
    unsigned* bar; unsigned x;
    volatile LAS unsigned* st;
};

__device__ __forceinline__ XcdBarrier xcd_barrier_post(unsigned* bar, volatile LAS unsigned* st) {
    XcdBarrier b; b.bar = bar; b.x = xb_xcc_id(); b.st = st;
    if (threadIdx.x == 0) (void)xb_add(&bar[XB_XCNT(b.x)], 1u);
    return b;
}
__device__ __forceinline__ void xcd_barrier_complete(unsigned* bar, unsigned x, unsigned& nloc, unsigned& nx) {
    const unsigned G = gridDim.x * gridDim.y * gridDim.z;
    unsigned sum, cnt, mine, sp = 0u;
    for (;;) {
        sum = 0u; cnt = 0u; mine = 0u;
#pragma unroll
        for (unsigned j = 0; j < 16; ++j) { const unsigned c = xb_ld(&bar[XB_XCNT(j)]); sum += c; cnt += (c > 0u) ? 1u : 0u; mine = (j == x) ? c : mine; }
        if (sum == G) break;
        __builtin_amdgcn_s_sleep(1);
        if ((++sp & 255u) == 0u) { if (xb_ld(&bar[XB_TMO])) break; if (sp > XB_SPIN_CAP) { atomicAdd(&bar[XB_TMO], 1u); break; } }
    }
    nloc = mine > 0u ? mine : 1u; nx = cnt > 0u ? cnt : 1u;
}

__device__ __forceinline__ void xcd_barrier(const XcdBarrier& b) {
    asm volatile("s_waitcnt vmcnt(0)" ::: "memory");
    __syncthreads();
    if (threadIdx.x == 0) {
        unsigned* bar = b.bar;
        __builtin_amdgcn_s_waitcnt(0);
        unsigned nloc = b.st[0], nx = b.st[1];
        if (nloc == 0u) { xcd_barrier_complete(bar, b.x, nloc, nx); b.st[0] = nloc; b.st[1] = nx; }
        const unsigned old = xb_add(&bar[XB_XSUB(b.x)], 1u);
        const unsigned gen = old / nloc;
        if (old + 1u == (gen + 1u) * nloc) {
            __builtin_amdgcn_fence(__ATOMIC_RELEASE, "agent");
            asm volatile("s_waitcnt vmcnt(0)" ::: "memory");
            const unsigned og = xb_add(&bar[XB_TOP], 1u);
            const unsigned tg = og / nx;
            asm volatile("buffer_inv sc1" ::: "memory");
            if (og + 1u == (tg + 1u) * nx) xb_add(&bar[XB_TOPGEN], 1u);
            else XB_SPIN(xb_ld(&bar[XB_TOPGEN]) == tg, bar);
            asm volatile("" ::: "memory");
            xb_add(&bar[XB_XGEN(b.x)], 1u);
            asm volatile("s_waitcnt vmcnt(0)" ::: "memory");
        } else {
            asm volatile("buffer_inv sc1" ::: "memory");
            XB_SPIN(xb_ld(&bar[XB_XGEN(b.x)]) == gen, bar);
            asm volatile("" ::: "memory");
            asm volatile("s_waitcnt vmcnt(0)" ::: "memory");
        }
    }
    __syncthreads();
}

__global__ void __launch_bounds__(NTHREADS, 2) mega_fwd(Args A_kernarg) {
    extern __shared__ __attribute__((aligned(16))) unsigned char lds_raw[];
    LAS unsigned char* lds = (LAS unsigned char*)lds_raw;
    cg::grid_group grid = cg::this_grid();
    { const int t0 = threadIdx.x; if (t0 < 64) ((LAS unsigned*)(lds + 131072))[t0] = 0u; }
    __syncthreads();
    (void)xcd_barrier_post((unsigned*)(ARGS.ws + OFF_CTL) + 4096, (volatile LAS unsigned*)(lds + 131072 + 32));
#define GSYNC1() do { XcdBarrier b_; b_.bar = (unsigned*)(ws + OFF_CTL) + 4096; b_.x = xb_xcc_id(); b_.st = (volatile LAS unsigned*)(lds + 131072 + 32); xcd_barrier(b_); } while (0)
#ifdef PROBE_SYNC
#define GSYNC() do { GSYNC1(); GSYNC1(); } while (0)
#else
#define GSYNC() GSYNC1()
#endif
    const int G = gridDim.x, bx = blockIdx.x;
    int qpos = 0;
#define ws (ARGS.ws)
#define out (ARGS.out)
#define mod ((const float*)(ws + OFF_MOD))
#define H ((bf16*)(ws + OFF_H))
#define ACT ((bf16*)(ws + OFF_ACT))
#define QB ((bf16*)(ws + OFF_Q))
#define KBUF ((bf16*)(ws + OFF_K))
#define VBUF ((bf16*)(ws + OFF_V))
#define OB ((bf16*)(ws + OFF_O))
#define ctl ((unsigned*)(ws + OFF_CTL))
#define SSLOT(s) ((float*)(ws + OFF_SS) + (size_t)(s) * NTOK)
#define SHWSLOT(s) ((const float*)(ws + OFF_SHW) + (size_t)(s) * 3 * 5632)


    prologue(lds, 0);
    if (out == nullptr) grid.sync();
    GSYNC();
    prologue(lds, 1);
    GSYNC();

#pragma unroll 1
    for (int l = 0; l < 4; ++l) {
        const int j = l >> 1;
#define modl (mod + (size_t)l * 3 * NMOD)
#define xp (l == 0 ? ARGS.x_prompt : (const float*)out)
#define xs (l == 0 ? ARGS.x_sample : (const float*)(out + (size_t)NCTX * DM))
#define xso (out + (size_t)NCTX * DM)
#pragma unroll 1
        for (int f = 0; f < 2; ++f) {
            if (f == 1) {
                if ((l & 1) == 0) {
                    { pg8::Gemm gm{H, (const bf16*)(ws + OFF_DQKV + j * SZ_DQKV), NTOK, 3072, DM}; pg8::StaticOrder S; S.init(NTOK, 3072, G, bx);
                      EpiDiffQKV E{QB, KBUF, VBUF, ARGS.diff_q_norm + j * 64, ARGS.diff_k_norm + j * 64, (const float*)(ws + OFF_TABD), out + OUT_DK, out + OUT_DV, j, SSLOT(l * 3 + 1), SHWSLOT(l * 3 + 1)};

#if !defined(ONLY) || ONLY == 1
      pg8::gemm_phase<EpiDiffQKV, pg8::StaticOrder, true, true>(lds, gm, S, E);
#endif
 }
                    GSYNC();
                    { const float* lp = ARGS.diff_lambda + j * 256; const int lane = opaque_tid() & 63;
                      const float s1 = wave_sum(lp[lane] * lp[64 + lane]), s2 = wave_sum(lp[128 + lane] * lp[192 + lane]);
                      int l_o = l; asm volatile("" : "+s"(l_o)); const float lam_init = l_o == 0 ? 0.2f : 0.47071301834358418f;
                      const float lam = __expf(s1) - __expf(s2) + lam_init;
                      AttnArgs a{QB, 1024, KBUF, 1024, VBUF, 1024, (const bf16*)(ws + OFF_KC) + (size_t)j * 512 * 1024, (const bf16*)(ws + OFF_VC) + (size_t)j * 512 * 1024, OB,
                                 nullptr, nullptr, ARGS.diff_subln + j * 128, lam, 1.f - lam_init, 0.125f * 1.4426950408889634f, ctl + l, 8};

#ifndef SKIP_ATTN
 attn_phase<2, 64, 128, false, 1>(lds, a);
#ifdef PROBE_ATT
 GSYNC(); a.ctr = ctl + 4 + l; attn_phase<2, 64, 128, false, 1>(lds, a);
#endif
#endif
 }
                    GSYNC();
                    { pg8::Gemm gm{OB, (const bf16*)(ws + OFF_DWO + j * SZ_WO), NTOK, DM, DM}; pg8::StaticOrder S; S.init(NTOK, DM, G, bx);
                      EpiResid E{out, xso, out, modl + 5 * 1024, 1.f, ARGS.norm_g + (size_t)(l * 3 + 2) * DM, modl + 7 * 1024, SSLOT(l * 3 + 2), H};

#if !defined(ONLY) || ONLY == 2
      pg8::gemm_phase<EpiResid, pg8::StaticOrder, true, true>(lds, gm, S, E);
#endif
 }
                    if (defer_ok()) { if (bx >= IDLE_160) deferred_slot(lds, qpos, QUOTA_OUT_PROJ, IDLE_160); qpos += QUOTA_OUT_PROJ; }
                    GSYNC();
                } else {
                    { pg8::Gemm gm{H, (const bf16*)(ws + OFF_MDOWN + j * SZ_MDOWN), NTOK, 1280, DM}; pg8::StaticOrder S; S.init(NTOK, 1280, G, bx);
                      EpiDownRaw E{(float*)(ws + OFF_DOWN), SSLOT(l * 3 + 1), SHWSLOT(l * 3 + 1)};

#if !defined(ONLY) || ONLY == 3
      pg8::gemm_phase<EpiDownRaw, pg8::StaticOrder, true, true>(lds, gm, S, E);
#endif
 }
                    GSYNC();
                    mla_norm_phase(j);
                    GSYNC();
                    { pg8::Gemm gm{(const bf16*)(ws + OFF_CQ), (const bf16*)(ws + OFF_MQUP + j * SZ_MQUP), NTOK, 1536, 768}; pg8::StaticOrder S; S.init(NTOK, 1536, G, bx);
                      EpiBf16Plain E{QB, 1536};

#if !defined(ONLY) || ONLY == 4
      pg8::gemm_phase<EpiBf16Plain, pg8::StaticOrder, true, true>(lds, gm, S, E);
#endif
 }
                    { pg8::Gemm gm{(const bf16*)(ws + OFF_CKV + j * SZ_CKV), (const bf16*)(ws + OFF_MKVUP + j * SZ_MKVUP), NKV, 2048, 256}; pg8::StaticOrder S; S.init(NKV, 2048, G, bx);
                      EpiKVup E{KBUF, VBUF, ARGS.mla_k_norm + j * 96, (const float*)(ws + OFF_KPE + j * SZ_KPE), (const float*)(ws + OFF_KPSS + j * SZ_KPSS), (const float*)(ws + OFF_TABM)};

#if !defined(ONLY) || ONLY == 5
      pg8::gemm_phase<EpiKVup, pg8::StaticOrder, true, true>(lds, gm, S, E);
#endif
 }
                    GSYNC();
                    { AttnArgs a{QB, 1536, KBUF, 1536, VBUF, 1024, KBUF + (size_t)NTOK * 1536, VBUF + (size_t)NTOK * 1024, OB,
                                 ARGS.mla_q_norm + j * 96, (const float*)(ws + OFF_TABM), nullptr, 0.f, 0.f, 0.10206207261596575f * 1.4426950408889634f, ctl + l, 16};

#ifndef SKIP_ATTN2
 attn_phase<1, 96, 64, true, 2>(lds, a);
#ifdef PROBE_ATT
 GSYNC(); a.ctr = ctl + 4 + l; attn_phase<1, 96, 64, true, 2>(lds, a);
#endif
#endif
 }
                    GSYNC();
                    { pg8::Gemm gm{OB, (const bf16*)(ws + OFF_MWO + j * SZ_WO), NTOK, DM, DM}; pg8::StaticOrder S; S.init(NTOK, DM, G, bx);
                      EpiResid E{out, xso, out, modl + 5 * 1024, 1.f, ARGS.norm_g + (size_t)(l * 3 + 2) * DM, modl + 7 * 1024, SSLOT(l * 3 + 2), H};

#if !defined(ONLY) || ONLY == 6
      pg8::gemm_phase<EpiResid, pg8::StaticOrder, true, true>(lds, gm, S, E);
#endif
 }
                    if (defer_ok()) { if (bx >= IDLE_160) deferred_slot(lds, qpos, QUOTA_OUT_PROJ, IDLE_160); qpos += QUOTA_OUT_PROJ; }
                    GSYNC();
                }
            }
            const bool first = (l == 0 && f == 0);
            { pg8::Gemm gm{H, (const bf16*)(ws + OFF_WIN + (size_t)(l * 2 + f) * SZ_WIN), NTOK, 2 * DFF, DM}; pg8::StaticOrder S; S.init(NTOK, 2 * DFF, G, bx);
              EpiSwiglu E{ACT, SSLOT(l * 3 + 2 * f), SHWSLOT(l * 3 + 2 * f)};

#if !defined(ONLY) || ONLY == 7
      pg8::gemm_phase<EpiSwiglu, pg8::StaticOrder, true, true>(lds, gm, S, E);
#endif
 }
            if (defer_ok()) { if (bx >= IDLE_FFN_IN) deferred_slot(lds, qpos, QUOTA_FFN_IN, IDLE_FFN_IN); qpos += QUOTA_FFN_IN; }
            GSYNC();
            { pg8::Gemm gm{ACT, (const bf16*)(ws + OFF_WOUT + (size_t)(l * 2 + f) * SZ_WOUT), NTOK, DM, DFF}; pg8::StaticOrder S; S.init(NTOK, DM, G, bx);
              const bool nonext = (l == 3 && f == 1);
              const float* gn = nonext ? (const float*)nullptr : (f == 0 ? ARGS.norm_g + (size_t)(l * 3 + 1) * DM : ARGS.norm_g + (size_t)((l + 1) * 3) * DM);
              const float* scn = f == 0 ? modl + 4 * 1024 : mod + (size_t)(l + 1) * 3 * NMOD + 1024;
              float* ssn = f == 0 ? SSLOT(l * 3 + 1) : SSLOT((l + 1) * 3);
              EpiResid E{first ? xp : out, first ? xs : xso, out, modl + (size_t)(2 + 6 * f) * 1024, 0.5f, gn, scn, ssn, H};

#if !defined(ONLY) || ONLY == 8
      pg8::gemm_phase<EpiResid, pg8::StaticOrder, true, true>(lds, gm, S, E);
#endif
 }
            if (defer_ok()) { if (bx >= IDLE_160) deferred_slot(lds, qpos, QUOTA_FFN_OUT, IDLE_160); qpos += QUOTA_FFN_OUT; }
            GSYNC();
        }
    }
}

#undef ws
#undef out
#undef mod
#undef H
#undef ACT
#undef QB
#undef KBUF
#undef VBUF
#undef OB
#undef ctl
#undef SSLOT
#undef SHWSLOT
#undef modl
#undef xp
#undef xs
#undef xso
extern "C" void kernel_launch(void* const* d_in, const int* in_sizes, int n_in, void* d_out, int out_size, void* d_ws, size_t ws_size, hipStream_t stream) {
    static int grid = 0;
    if (grid == 0) {
        if (n_in != 27 || (size_t)out_size != OUT_TOTAL || ws_size < WS_END) { fprintf(stderr, "kernel_launch: unexpected shapes (n_in %d, out %d, ws %zu, need %zu)\n", n_in, out_size, ws_size, (size_t)WS_END); grid = -1; return; }
        int dev = 0, cus = 0, per_cu = 0;
        hipGetDevice(&dev);
        hipDeviceGetAttribute(&cus, hipDeviceAttributeMultiprocessorCount, dev);
        hipFuncSetAttribute((const void*)mega_fwd, hipFuncAttributeMaxDynamicSharedMemorySize, LDS_BYTES);
        hipOccupancyMaxActiveBlocksPerMultiprocessor(&per_cu, (const void*)mega_fwd, NTHREADS, LDS_BYTES);
        if (per_cu < 1) { fprintf(stderr, "kernel_launch: occupancy query says %d blocks per CU\n", per_cu); grid = -1; return; }
        grid = cus * 1;
    }
    if (grid < 0) return;
    hipMemsetAsync((char*)d_ws + OFF_CTL, 0, 65536, stream);
    Args a{};
    const float** ap = (const float**)&a;
    for (int i = 0; i < 27; ++i) ap[i] = (const float*)d_in[i];
    a.out = (float*)d_out; a.ws = (unsigned char*)d_ws;
    void* args[] = {&a};
    hipError_t e = hipLaunchCooperativeKernel((const void*)mega_fwd, dim3(grid), dim3(NTHREADS), args, LDS_BYTES, stream);
    if (e != hipSuccess) fprintf(stderr, "cooperative launch failed: %s (grid %d)\n", hipGetErrorString(e), grid);
}
```

```cpp
#include <hip/hip_runtime.h>
#include <hip/hip_cooperative_groups.h>
#include <cstdio>
#include <cstdint>
namespace cg = cooperative_groups;
#define RESID_BATCH_M 2
namespace pg8 {
#define PG8_LAS __attribute__((address_space(3)))
typedef unsigned short bf16_t;
typedef short bf16x8 __attribute__((ext_vector_type(8)));
typedef float f32x4 __attribute__((ext_vector_type(4)));
typedef unsigned u32x4 __attribute__((ext_vector_type(4)));
constexpr int BM = 256, BK = 64, HALF = 128, HTB = HALF * BK * 2  , STAGE_BYTES = 8 * HTB, NXCD = 8, WGM = 8;

__host__ __device__ __forceinline__ int lds_byte(int r, int c) { const int st = (r >> 4) * 2 + (c >> 5), rr = r & 15, cc = c & 31, ob = rr * 64 + cc * 2; return st * 1024 + (ob ^ (((ob >> 9) & 1) << 5)); }
__host__ __device__ __forceinline__ void stage_rc(int b, int& R, int& C) { const int st = b / 1024, sb = b % 1024, swz = sb ^ (((sb >> 9) & 1) << 5); R = (st >> 1) * 16 + swz / 64; C = (st & 1) * 32 + (swz % 64) / 2; }
__host__ __device__ __forceinline__ int perm32(int rho) { const int n = rho >> 4, i = rho & 15; return 8 * (i >> 2) + 4 * n + (i & 3); }

struct Unit { int pm, pn; };
struct Gemm { const bf16_t* A; const bf16_t* Bt; int M, N, K; };

struct StaticOrder {
    int nM, nN, nwg, G, c;
    __host__ __device__ void init(int M, int N, int G_, int c_) { nM = M / BM; nN = N / BM; nwg = nM * nN; G = G_; c = c_; }
    __host__ __device__ bool next(int i, Unit& u) const {
        const long L = (long)i * G + c; if (L >= nwg) return false;
        int wgid = (int)L; { const int q = nwg / NXCD, r = nwg % NXCD, xcd = wgid % NXCD, off = wgid / NXCD; wgid = (xcd < r ? xcd * (q + 1) : r * (q + 1) + (xcd - r) * q) + off; }
        const int nig = WGM * nN, gid = wgid / nig, fm = gid * WGM, gsz = (nM - fm) < WGM ? (nM - fm) : WGM;
        u.pm = fm + ((wgid % nig) % gsz); u.pn = (wgid % nig) / gsz; return true;
    }
    __device__ __forceinline__ void a_ready(const Unit&) const {}
    __device__ __forceinline__ void done(const Unit&) const {}
};

__device__ __forceinline__ unsigned cvt_pk_bf16(float lo, float hi) { unsigned r; asm volatile("v_cvt_pk_bf16_f32 %0, %1, %2" : "=v"(r) : "v"(lo), "v"(hi)); return r; }
typedef float f32x2 __attribute__((ext_vector_type(2)));
template <class Epi, class Sched, bool ALIGN_EPI = false, bool SP2 = false>
__device__ __forceinline__ void gemm_phase(PG8_LAS unsigned char* lds, const Gemm g, const Sched& S, const Epi& E) {
    int tid_o = threadIdx.x; asm volatile("" : "+v"(tid_o));
    const int tid = tid_o, wid = __builtin_amdgcn_readfirstlane(tid >> 6), lane = tid & 63, wr = wid >> 2, wc = wid & 3, fr = lane & 15, fq = lane >> 4;
    int K_o = g.K; asm volatile("" : "+s"(K_o)); const int K = K_o, nt = K / BK;
    unsigned voffA[2], voffB[2];
#pragma unroll
    for (int i = 0; i < 2; ++i) { int R, C; stage_rc(tid * 16 + i * 8192, R, C); const int Rb = Epi::PERM ? ((R & ~31) + perm32(R & 31)) : R;
        voffA[i] = (unsigned)(R * K + C) * 2u; voffB[i] = (unsigned)(Rb * K + C) * 2u; }
    const size_t kstep = (size_t)(BK * 2);
    const size_t hstep = (size_t)HALF * K * 2;
    const size_t tstep = 2 * hstep;
    const unsigned ldsw = (unsigned)wid * 1024u;
    const int aoff = lds_byte(wr * 64 + fr, fq * 8), boff = lds_byte(wc * 32 + fr, fq * 8);
#define PG8_SA(b, h) (((b) * 2 + (h)) * HTB)
#define PG8_SB(b, h) ((4 + (b) * 2 + (h)) * HTB)
#define PG8_STAGE(bufoff, gbase, voff) do { _Pragma("unroll") for (int _i = 0; _i < 2; ++_i) \
        __builtin_amdgcn_global_load_lds((const unsigned*)((const char*)(gbase) + (voff)[_i]), (PG8_LAS unsigned*)(lds + (bufoff) + ldsw + _i * 8192), 16, 0, 0); } while (0)
#define PG8_LDA(dst, b, h) do { _Pragma("unroll") for (int m = 0; m < 4; ++m) _Pragma("unroll") for (int k = 0; k < 2; ++k) dst[m][k] = *(const PG8_LAS bf16x8*)(lds + PG8_SA(b, h) + aoff + m * 2048 + k * 1024); } while (0)
#define PG8_LDB(dst, b, h) do { _Pragma("unroll") for (int n = 0; n < 2; ++n) _Pragma("unroll") for (int k = 0; k < 2; ++k) dst[n][k] = *(const PG8_LAS bf16x8*)(lds + PG8_SB(b, h) + boff + n * 2048 + k * 1024); } while (0)
#define PG8_MMA(ai, bj, At, Bt) do { __builtin_amdgcn_s_setprio(1); _Pragma("unroll") for (int m = 0; m < 4; ++m) _Pragma("unroll") for (int n = 0; n < 2; ++n) _Pragma("unroll") for (int k = 0; k < 2; ++k) \
        acc[ai][bj][m][n] = __builtin_amdgcn_mfma_f32_16x16x32_bf16(Bt[n][k], At[m][k], acc[ai][bj][m][n], 0, 0, 0); __builtin_amdgcn_s_setprio(0); } while (0)
#define PG8_WAIT_V(n) asm volatile("s_waitcnt vmcnt(" #n ")" ::: "memory")
#define PG8_WAIT_L(n) asm volatile("s_waitcnt lgkmcnt(" #n ")" ::: "memory")
#define PG8_BAR __builtin_amdgcn_s_barrier()
#define PG8_SCHED __builtin_amdgcn_sched_barrier(0)
    Unit cur, nxt; int ui = 0;
    if (!S.next(0, cur)) return;
    f32x4 acc[2][2][4][2];
#pragma unroll
    for (int a = 0; a < 2; ++a)
#pragma unroll
        for (int b = 0; b < 2; ++b)
#pragma unroll
            for (int m = 0; m < 4; ++m)
#pragma unroll
                for (int n = 0; n < 2; ++n) acc[a][b][m][n] = (f32x4){0.f, 0.f, 0.f, 0.f};
    bf16x8 At[4][2], B0[2][2], B1[2][2];
    const char* cA = (const char*)g.A + (size_t)cur.pm * tstep; const char* cB = (const char*)g.Bt + (size_t)cur.pn * tstep;
    S.a_ready(cur);
    if constexpr (SP2) {
        PG8_STAGE(PG8_SB(0, 0), cB, voffB); PG8_STAGE(PG8_SB(0, 1), cB + hstep, voffB); PG8_STAGE(PG8_SA(0, 0), cA, voffA); PG8_STAGE(PG8_SA(0, 1), cA + hstep, voffA);
        if (wr == 1) PG8_BAR;
        PG8_WAIT_V(2); PG8_BAR;
        PG8_STAGE(PG8_SB(1, 0), cB + kstep, voffB); PG8_STAGE(PG8_SA(1, 0), cA + kstep, voffA); PG8_STAGE(PG8_SB(1, 1), cB + hstep + kstep, voffB);
        PG8_WAIT_V(6); PG8_BAR;
    } else {
        PG8_STAGE(PG8_SB(0, 0), cB, voffB); PG8_STAGE(PG8_SA(0, 0), cA, voffA); PG8_STAGE(PG8_SB(0, 1), cB + hstep, voffB); PG8_STAGE(PG8_SA(0, 1), cA + hstep, voffA);
        if (wr == 1) PG8_BAR;
        PG8_WAIT_V(4); PG8_BAR;
        PG8_STAGE(PG8_SB(1, 0), cB + kstep, voffB); PG8_STAGE(PG8_SA(1, 0), cA + kstep, voffA); PG8_STAGE(PG8_SB(1, 1), cB + hstep + kstep, voffB);
        PG8_WAIT_V(6); PG8_BAR;
    }
    for (;;) {
        const bool has_next = S.next(ui + 1, nxt);
        const char* nA = has_next ? (const char*)g.A + (size_t)nxt.pm * tstep : cA; const char* nB = has_next ? (const char*)g.Bt + (size_t)nxt.pn * tstep : cB;
        for (int t = 0; t < nt; t += 2) {
            const bool last = (t == nt - 2);
            const char* a1 = cA + (size_t)(t + 1) * kstep;
            const char* a2 = last ? nA : cA + (size_t)(t + 2) * kstep; const char* b2 = last ? nB : cB + (size_t)(t + 2) * kstep;
            const char* a3 = a2 + kstep; const char* b3 = b2 + kstep;
            if (last && has_next) S.a_ready(nxt);
            if constexpr (SP2) {
            PG8_LDB(B0, 0, 0); PG8_LDB(B1, 0, 1); PG8_SCHED; PG8_LDA(At, 0, 0); PG8_STAGE(PG8_SA(1, 1), a1 + hstep, voffA);
            PG8_WAIT_V(8); PG8_WAIT_L(0); PG8_BAR; PG8_MMA(0, 0, At, B0); PG8_MMA(0, 1, At, B1); PG8_BAR; PG8_SCHED;
            PG8_LDA(At, 0, 1); PG8_STAGE(PG8_SB(0, 0), b2, voffB); PG8_STAGE(PG8_SB(0, 1), b2 + hstep, voffB); PG8_STAGE(PG8_SA(0, 0), a2, voffA);
            PG8_WAIT_V(8); PG8_WAIT_L(0); PG8_BAR; PG8_MMA(1, 0, At, B0); PG8_MMA(1, 1, At, B1); PG8_BAR; PG8_SCHED;
            PG8_LDB(B0, 1, 0); PG8_LDB(B1, 1, 1); PG8_SCHED; PG8_LDA(At, 1, 0); PG8_STAGE(PG8_SA(0, 1), a2 + hstep, voffA);
            PG8_WAIT_V(8); PG8_WAIT_L(0); PG8_BAR; PG8_MMA(0, 0, At, B0); PG8_MMA(0, 1, At, B1); PG8_BAR; PG8_SCHED;
            PG8_LDA(At, 1, 1); PG8_STAGE(PG8_SB(1, 0), b3, voffB); PG8_STAGE(PG8_SB(1, 1), b3 + hstep, voffB); PG8_STAGE(PG8_SA(1, 0), a3, voffA);
            PG8_WAIT_V(8); PG8_WAIT_L(0); PG8_BAR; PG8_MMA(1, 0, At, B0); PG8_MMA(1, 1, At, B1); PG8_BAR; PG8_SCHED;
            } else {
            PG8_LDB(B0, 0, 0); PG8_SCHED; PG8_LDA(At, 0, 0); PG8_STAGE(PG8_SA(1, 1), a1 + hstep, voffA);
            PG8_WAIT_L(8); PG8_BAR; PG8_WAIT_L(0); PG8_MMA(0, 0, At, B0); PG8_BAR; PG8_SCHED;
            PG8_LDB(B1, 0, 1); PG8_STAGE(PG8_SB(0, 0), b2, voffB);
            PG8_BAR; PG8_WAIT_L(0); PG8_MMA(0, 1, At, B1); PG8_BAR;
            PG8_LDA(At, 0, 1); PG8_STAGE(PG8_SA(0, 0), a2, voffA);
            PG8_BAR; PG8_WAIT_L(0); PG8_MMA(1, 0, At, B0); PG8_BAR; PG8_SCHED;
            PG8_STAGE(PG8_SB(0, 1), b2 + hstep, voffB);
            PG8_WAIT_V(6); PG8_BAR; PG8_MMA(1, 1, At, B1); PG8_BAR;
            PG8_LDB(B0, 1, 0); PG8_SCHED; PG8_LDA(At, 1, 0); PG8_STAGE(PG8_SA(0, 1), a2 + hstep, voffA);
            PG8_WAIT_L(8); PG8_BAR; PG8_WAIT_L(0); PG8_MMA(0, 0, At, B0); PG8_BAR; PG8_SCHED;
            PG8_LDB(B1, 1, 1); PG8_STAGE(PG8_SB(1, 0), b3, voffB);
            PG8_BAR; PG8_WAIT_L(0); PG8_MMA(0, 1, At, B1); PG8_BAR;
            PG8_LDA(At, 1, 1); PG8_STAGE(PG8_SA(1, 0), a3, voffA);
            PG8_BAR; PG8_WAIT_L(0); PG8_MMA(1, 0, At, B0); PG8_BAR; PG8_SCHED;
            PG8_STAGE(PG8_SB(1, 1), b3 + hstep, voffB);
            PG8_WAIT_V(6); PG8_BAR; PG8_MMA(1, 1, At, B1); PG8_BAR;
            }
        }
        if constexpr (ALIGN_EPI) { if (wr == 0) PG8_BAR; }
        if constexpr (!Epi::AFTER_DRAIN) { E(acc, cur, wr, wc, fr, fq); S.done(cur); }
        if (!has_next) break;
#pragma unroll
        for (int a = 0; a < 2; ++a)
#pragma unroll
            for (int b = 0; b < 2; ++b)
#pragma unroll
                for (int m = 0; m < 4; ++m)
#pragma unroll
                    for (int n = 0; n < 2; ++n) acc[a][b][m][n] = (f32x4){0.f, 0.f, 0.f, 0.f};
        cur = nxt; cA = nA; cB = nB; ++ui;
        if constexpr (ALIGN_EPI) { if (wr == 1) PG8_BAR; }
    }
    PG8_WAIT_V(0);
    if constexpr (!ALIGN_EPI) { if (wr == 0) PG8_BAR; }
    PG8_BAR;
    if constexpr (Epi::AFTER_DRAIN) { E.fused(acc, cur, wr, wc, fr, fq, lds, wid, lane); S.done(cur); }
#undef PG8_SA
#undef PG8_SB
#undef PG8_STAGE
#undef PG8_LDA
#undef PG8_LDB
#undef PG8_MMA
#undef PG8_WAIT_V
#undef PG8_WAIT_L
#undef PG8_BAR
#undef PG8_SCHED
}
}

#define GAS __attribute__((address_space(1)))
#define LAS __attribute__((address_space(3)))
typedef unsigned short bf16;
typedef unsigned u32x4 __attribute__((ext_vector_type(4)));
typedef unsigned u32x2 __attribute__((ext_vector_type(2)));
typedef float f32x4 __attribute__((ext_vector_type(4)));
typedef float f32x2 __attribute__((ext_vector_type(2)));
typedef short bf16x8 __attribute__((ext_vector_type(8)));
typedef short s16x4 __attribute__((ext_vector_type(4)));

constexpr int DM = 1024, NCTX = 8192, NLAT = 2048, NTOK = 10240, NKV = 10752, DFF = 2816, NMOD = 9216;
constexpr int NWAVES = 8, NTHREADS = 512;
constexpr float EPS = 1e-6f;
constexpr int LDS_BYTES = 147456;

constexpr size_t OUT_X = 0;
constexpr size_t OUT_DK = (size_t)NTOK * DM;
constexpr size_t OUT_DV = OUT_DK + (size_t)32 * 2 * 256 * 1024;
constexpr size_t OUT_CKV = OUT_DV + (size_t)32 * 2 * 256 * 1024;
constexpr size_t OUT_KPE = OUT_CKV + (size_t)32 * 2 * 256 * 256;
constexpr size_t OUT_TOTAL = OUT_KPE + (size_t)32 * 2 * 256 * 32;

constexpr size_t al4k(size_t x) { return (x + 4095) & ~(size_t)4095; }
constexpr size_t OFF_CTL = 0;
constexpr size_t OFF_MOD = 1u << 20;
constexpr size_t OFF_TABD = OFF_MOD + al4k((size_t)4 * 3 * NMOD * 4);
constexpr size_t OFF_TABM = OFF_TABD + al4k(64 * 16 * 2 * 4);
constexpr size_t SZ_WIN = (size_t)2 * DFF * DM * 2, SZ_WOUT = (size_t)DM * DFF * 2;
constexpr size_t OFF_WIN = OFF_TABM + al4k(64 * 8 * 2 * 4);
constexpr size_t OFF_WOUT = OFF_WIN + 8 * SZ_WIN;
constexpr size_t SZ_DQKV = (size_t)3072 * 1024 * 2, SZ_WO = (size_t)1024 * 1024 * 2, SZ_MDOWN = (size_t)1280 * 1024 * 2, SZ_MQUP = (size_t)1536 * 768 * 2, SZ_MKVUP = (size_t)2048 * 256 * 2;
constexpr size_t OFF_DQKV = OFF_WOUT + 8 * SZ_WOUT;
constexpr size_t OFF_DWO = OFF_DQKV + 2 * SZ_DQKV;
constexpr size_t OFF_MDOWN = OFF_DWO + 2 * SZ_WO;
constexpr size_t OFF_MQUP = OFF_MDOWN + 2 * SZ_MDOWN;
constexpr size_t OFF_MKVUP = OFF_MQUP + 2 * SZ_MQUP;
constexpr size_t OFF_MWO = OFF_MKVUP + 2 * SZ_MKVUP;
constexpr size_t OFF_H = OFF_MWO + 2 * SZ_WO;
constexpr size_t OFF_ACT = OFF_H + (size_t)NTOK * DM * 2;
constexpr size_t OFF_Q = OFF_ACT + (size_t)NTOK * DFF * 2;
constexpr size_t OFF_K = OFF_Q + (size_t)NTOK * 1536 * 2;
constexpr size_t OFF_V = OFF_K + (size_t)NKV * 1536 * 2;
constexpr size_t OFF_O = OFF_V + (size_t)NKV * 1024 * 2;
constexpr size_t OFF_KC = OFF_O + (size_t)NTOK * DM * 2;
constexpr size_t OFF_VC = OFF_KC + (size_t)2 * 512 * 1024 * 2;
constexpr size_t OFF_DOWN = OFF_VC + (size_t)2 * 512 * 1024 * 2;
constexpr size_t OFF_CQ = OFF_DOWN + (size_t)NTOK * 1056 * 4;
constexpr size_t SZ_CKV = (size_t)NKV * 256 * 2, SZ_KPE = (size_t)NKV * 32 * 4, SZ_KPSS = al4k((size_t)NKV * 4);
constexpr size_t OFF_CKV = OFF_CQ + (size_t)NTOK * 768 * 2;
constexpr size_t OFF_KPE = OFF_CKV + 2 * SZ_CKV;
constexpr size_t OFF_KPSS = OFF_KPE + 2 * SZ_KPE;
constexpr size_t OFF_SS = OFF_KPSS + 2 * SZ_KPSS;
constexpr size_t OFF_SHW = OFF_SS + (size_t)12 * NTOK * 4;
constexpr size_t WS_END = OFF_SHW + (size_t)12 * 3 * 5632 * 4;

struct Args {
    const float* x_prompt; const float* x_sample; const float* c; const float* cache_diff_k; const float* cache_diff_v; const float* cache_mla_ckv; const float* cache_mla_kpe; const float* c_ctx;
    const float* w_mod; const float* b_mod; const float* norm_g; const float* ffn_w_in; const float* ffn_w_out;
    const float* diff_w_qkv; const float* diff_q_norm; const float* diff_k_norm; const float* diff_lambda; const float* diff_subln; const float* diff_w_o;
    const float* mla_w_down; const float* mla_q_a_norm; const float* mla_kv_a_norm; const float* mla_w_q_up; const float* mla_w_kv_up; const float* mla_q_norm; const float* mla_k_norm; const float* mla_w_o;
    float* out; unsigned char* ws;
};

typedef const Args __attribute__((address_space(4))) CArgs;
__device__ __forceinline__ CArgs* KA() { CArgs* p = (CArgs*)__builtin_amdgcn_kernarg_segment_ptr(); asm volatile("" : "+s"(p)); return p; }
#define ARGS (*KA())
__device__ __forceinline__ int opaque_tid() { int t = threadIdx.x; asm volatile("" : "+v"(t)); return t; }
__device__ __forceinline__ unsigned f2bf(float f) { unsigned u = __builtin_bit_cast(unsigned, f); return (u + 0x7fffu + ((u >> 16) & 1u)) >> 16; }
__device__ __forceinline__ unsigned pk2(float lo, float hi) { return pg8::cvt_pk_bf16(lo, hi); }
__device__ __forceinline__ float bf2f(unsigned short b) { return __builtin_bit_cast(float, (unsigned)b << 16); }
__device__ __forceinline__ float wave_sum(float v) {
#pragma unroll
    for (int o = 1; o < 64; o <<= 1) v += __shfl_xor(v, o);
    return v;
}
__device__ __forceinline__ float quad_sum(float v) { v += __shfl_xor(v, 16); v += __shfl_xor(v, 32); return v; }
__device__ __forceinline__ float quad_max(float v) { v = fmaxf(v, __shfl_xor(v, 16)); v = fmaxf(v, __shfl_xor(v, 32)); return v; }
__device__ __forceinline__ float fast_silu(float g) { return g * __builtin_amdgcn_rcpf(1.f + __builtin_amdgcn_exp2f(-1.4426950408889634f * g)); }
__device__ __forceinline__ u32x4 pack8(const float* v) { u32x4 w; w.x = pk2(v[0], v[1]); w.y = pk2(v[2], v[3]); w.z = pk2(v[4], v[5]); w.w = pk2(v[6], v[7]); return w; }
__device__ __forceinline__ int tok_group(int row) { return row < NCTX ? 0 : 1 + ((row - NCTX) >> 10); }

#define EPI_VALS(v, ai, bj, m) float v[8]; { _Pragma("unroll") for (int _n = 0; _n < 2; ++_n) _Pragma("unroll") for (int _j = 0; _j < 4; ++_j) v[_n * 4 + _j] = acc[ai][bj][m][_n][_j]; }

#define EPI_NORMIN_DECL const float* ss; const float* shw;
#define EPI_NORMIN_SW(sw, u, wc, fq) float sw[2][8]; { const float* sp_ = shw + (size_t)tok_group((u).pm * 256) * 5632 + (u).pn * 256 + (wc) * 32 + 8 * (fq); \
    _Pragma("unroll") for (int bj_ = 0; bj_ < 2; ++bj_) { const f32x4 a_ = *(const f32x4*)(sp_ + bj_ * 128), b_ = *(const f32x4*)(sp_ + bj_ * 128 + 4); \
        sw[bj_][0] = a_.x; sw[bj_][1] = a_.y; sw[bj_][2] = a_.z; sw[bj_][3] = a_.w; sw[bj_][4] = b_.x; sw[bj_][5] = b_.y; sw[bj_][6] = b_.z; sw[bj_][7] = b_.w; } }
#define EPI_NORMIN_RSTD(rs, row0) float rs[2][4]; { _Pragma("unroll") for (int ai_ = 0; ai_ < 2; ++ai_) _Pragma("unroll") for (int m_ = 0; m_ < 4; ++m_) rs[ai_][m_] = ss[(row0) + ai_ * 128 + m_ * 16]; \
    _Pragma("unroll") for (int ai_ = 0; ai_ < 2; ++ai_) _Pragma("unroll") for (int m_ = 0; m_ < 4; ++m_) rs[ai_][m_] = __builtin_amdgcn_rsqf(rs[ai_][m_] * (1.f / DM) + EPS); }
#define EPI_NORMIN_APPLY(v, bj, rstd, sw) { _Pragma("unroll") for (int i_ = 0; i_ < 8; ++i_) v[i_] = v[i_] * (rstd) + sw[bj][i_]; }

struct EpiSwiglu {
    static constexpr bool PERM = true, AFTER_DRAIN = false;
    bf16* ACT; EPI_NORMIN_DECL
    __device__ __forceinline__ void operator()(const pg8::f32x4 (&acc)[2][2][4][2], const pg8::Unit& u, int wr, int wc, int fr, int fq) const {
        const int row0 = u.pm * 256 + wr * 64 + fr, col = u.pn * 128 + wc * 32 + 8 * fq;
        EPI_NORMIN_SW(sw, u, wc, fq);
        EPI_NORMIN_RSTD(rsv, row0);
#pragma unroll
        for (int ai = 0; ai < 2; ++ai)
#pragma unroll
            for (int m = 0; m < 4; ++m) {
                EPI_VALS(g, ai, 0, m); EPI_VALS(uu, ai, 1, m);
                const float rstd = rsv[ai][m];
                EPI_NORMIN_APPLY(g, 0, rstd, sw); EPI_NORMIN_APPLY(uu, 1, rstd, sw);
                float r[8];
#pragma unroll
                for (int i = 0; i < 8; ++i) r[i] = fast_silu(g[i]) * uu[i];
                *(u32x4*)(ACT + (size_t)(row0 + ai * 128 + m * 16) * DFF + col) = pack8(r);
            }
    }
};

struct EpiResid {
    static constexpr bool PERM = true, AFTER_DRAIN = false;
    const float* xp; const float* xs; float* out; const float* gate; float scale;
    const float* gnext; const float* scnext; float* ssnext; bf16* XG;
    __device__ __forceinline__ void operator()(const pg8::f32x4 (&acc)[2][2][4][2], const pg8::Unit& u, int wr, int wc, int fr, int fq) const {
        const int row0 = u.pm * 256 + wr * 64 + fr, cb = u.pn * 256 + wc * 32 + 8 * fq;
        const int grp = tok_group(u.pm * 256);
        float gv[2][8];
#pragma unroll
        for (int bj = 0; bj < 2; ++bj) { const f32x4 a = *(const f32x4*)(gate + (size_t)grp * NMOD + cb + bj * 128), b = *(const f32x4*)(gate + (size_t)grp * NMOD + cb + bj * 128 + 4);
            gv[bj][0] = a.x * scale; gv[bj][1] = a.y * scale; gv[bj][2] = a.z * scale; gv[bj][3] = a.w * scale; gv[bj][4] = b.x * scale; gv[bj][5] = b.y * scale; gv[bj][6] = b.z * scale; gv[bj][7] = b.w * scale; }
        const bool hasnext = gnext != nullptr;
        float gsv[2][8];
        if (hasnext) {
#pragma unroll
            for (int bj = 0; bj < 2; ++bj) { const f32x4 a = *(const f32x4*)(gnext + cb + bj * 128), b = *(const f32x4*)(gnext + cb + bj * 128 + 4);
                const f32x4 c = *(const f32x4*)(scnext + (size_t)grp * NMOD + cb + bj * 128), d = *(const f32x4*)(scnext + (size_t)grp * NMOD + cb + bj * 128 + 4);
                gsv[bj][0] = a.x * (1.f + c.x); gsv[bj][1] = a.y * (1.f + c.y); gsv[bj][2] = a.z * (1.f + c.z); gsv[bj][3] = a.w * (1.f + c.w);
                gsv[bj][4] = b.x * (1.f + d.x); gsv[bj][5] = b.y * (1.f + d.y); gsv[bj][6] = b.z * (1.f + d.z); gsv[bj][7] = b.w * (1.f + d.w); }
        }
#ifndef RESID_BATCH_M
#define RESID_BATCH_M 4
#endif
#pragma unroll
        for (int ai = 0; ai < 2; ++ai)
#pragma unroll
            for (int mb = 0; mb < 4; mb += RESID_BATCH_M) {
                f32x4 xl[RESID_BATCH_M][2][2];
#pragma unroll
                for (int mm = 0; mm < RESID_BATCH_M; ++mm) { const int row = row0 + ai * 128 + (mb + mm) * 16;
                    const float* xo = row < NCTX ? xp + (size_t)row * DM : xs + (size_t)(row - NCTX) * DM;
#pragma unroll
                    for (int bj = 0; bj < 2; ++bj) { xl[mm][bj][0] = *(const f32x4*)(xo + cb + bj * 128); xl[mm][bj][1] = *(const f32x4*)(xo + cb + bj * 128 + 4); } }
#pragma unroll
                for (int mm = 0; mm < RESID_BATCH_M; ++mm) {
                    const int m = mb + mm;
                    const int row = row0 + ai * 128 + m * 16;
                    float* o = out + (size_t)row * DM;
                    float ssl = 0.f;
#pragma unroll
                    for (int bj = 0; bj < 2; ++bj) {
                        EPI_VALS(v, ai, bj, m);
                        const f32x4 x0 = xl[mm][bj][0], x1 = xl[mm][bj][1];
                        float xn[8];
                        xn[0] = x0.x + gv[bj][0] * v[0]; xn[1] = x0.y + gv[bj][1] * v[1]; xn[2] = x0.z + gv[bj][2] * v[2]; xn[3] = x0.w + gv[bj][3] * v[3];
                        xn[4] = x1.x + gv[bj][4] * v[4]; xn[5] = x1.y + gv[bj][5] * v[5]; xn[6] = x1.z + gv[bj][6] * v[6]; xn[7] = x1.w + gv[bj][7] * v[7];
                        *(f32x4*)(o + cb + bj * 128) = (f32x4){xn[0], xn[1], xn[2], xn[3]}; *(f32x4*)(o + cb + bj * 128 + 4) = (f32x4){xn[4], xn[5], xn[6], xn[7]};
                        if (hasnext) {
#pragma unroll
                            for (int i = 0; i < 8; ++i) { ssl += xn[i] * xn[i]; xn[i] *= gsv[bj][i]; }
                            *(u32x4*)(XG + (size_t)row * DM + cb + bj * 128) = pack8(xn);
                        }
                    }
                    if (hasnext) { ssl = quad_sum(ssl); if (fq == 0) __hip_atomic_fetch_add(ssnext + row, ssl, __ATOMIC_RELAXED, __HIP_MEMORY_SCOPE_AGENT); }
                }
            }
    }
};

struct EpiDiffQKV {
    static constexpr bool PERM = true, AFTER_DRAIN = false;
    bf16* Q; bf16* K; bf16* V; const float* qg; const float* kg; const float* tabD; float* out_k; float* out_v; int j; EPI_NORMIN_DECL
    __device__ __forceinline__ void operator()(const pg8::f32x4 (&acc)[2][2][4][2], const pg8::Unit& u, int wr, int wc, int fr, int fq) const {
        const int row0 = u.pm * 256 + wr * 64 + fr;
        const int G = 4 * u.pn + wc, type = G >> 4, hc = G & 15;
        const bool lat = u.pm >= 32;
        EPI_NORMIN_SW(sw, u, wc, fq);
        EPI_NORMIN_RSTD(rsv, row0);
        float gain[2][8];
        if (type < 2) { const float* gp = type == 0 ? qg : kg;
#pragma unroll
            for (int bj = 0; bj < 2; ++bj)
#pragma unroll
                for (int i = 0; i < 8; ++i) gain[bj][i] = gp[32 * bj + 8 * fq + i]; }
#pragma unroll
        for (int ai = 0; ai < 2; ++ai)
#pragma unroll
            for (int m = 0; m < 4; ++m) {
                __builtin_amdgcn_sched_barrier(0);
                const int row = row0 + ai * 128 + m * 16;
                EPI_VALS(v0, ai, 0, m); EPI_VALS(v1, ai, 1, m);
                { const float rstd_in = rsv[ai][m]; EPI_NORMIN_APPLY(v0, 0, rstd_in, sw); EPI_NORMIN_APPLY(v1, 1, rstd_in, sw); }
                const size_t dcol = (size_t)hc * 64 + 8 * fq;
                if (type < 2) {
                    float ss = 0.f;
#pragma unroll
                    for (int i = 0; i < 8; ++i) ss += v0[i] * v0[i] + v1[i] * v1[i];
                    ss = quad_sum(ss);
                    const float rstd = __builtin_amdgcn_rsqf(ss * (1.f / 64.f) + EPS);
#pragma unroll
                    for (int i = 0; i < 8; ++i) { v0[i] = v0[i] * rstd * gain[0][i]; v1[i] = v1[i] * rstd * gain[1][i]; }
                    if (lat) {
                        const int t = (row - NCTX) & 1023, prow = t >> 6, pcol = t & 63;
                        const float* t0 = tabD + (size_t)(prow * 16 + 8 * (fq & 1)) * 2; const float* t1 = tabD + (size_t)(pcol * 16 + 8 * (fq & 1)) * 2;
#pragma unroll
                        for (int i = 0; i < 8; ++i) {
                            const float p0 = __shfl_xor(v0[i], 32), p1 = __shfl_xor(v1[i], 32);
                            const float c0 = t0[2 * i], s0 = t0[2 * i + 1], c1 = t1[2 * i], s1 = t1[2 * i + 1];
                            v0[i] = fq < 2 ? v0[i] * c0 - p0 * s0 : v0[i] * c0 + p0 * s0;
                            v1[i] = fq < 2 ? v1[i] * c1 - p1 * s1 : v1[i] * c1 + p1 * s1;
                        }
                    }
                    bf16* dst = (type == 0 ? Q : K) + (size_t)row * 1024 + dcol;
                    *(u32x4*)(dst) = pack8(v0); *(u32x4*)(dst + 32) = pack8(v1);
                    if (type == 1 && !lat) {
                        const int b = row >> 8, s = row & 255;
                        float* o = out_k + ((size_t)(b * 2 + j) * 256 + s) * 1024 + dcol;
                        *(f32x4*)(o) = (f32x4){v0[0], v0[1], v0[2], v0[3]}; *(f32x4*)(o + 4) = (f32x4){v0[4], v0[5], v0[6], v0[7]};
                        *(f32x4*)(o + 32) = (f32x4){v1[0], v1[1], v1[2], v1[3]}; *(f32x4*)(o + 36) = (f32x4){v1[4], v1[5], v1[6], v1[7]};
                    }
                } else {
                    bf16* dst = V + (size_t)row * 1024 + dcol;
                    *(u32x4*)(dst) = pack8(v0); *(u32x4*)(dst + 32) = pack8(v1);
                    if (!lat) {
                        const int b = row >> 8, s = row & 255;
                        float* o = out_v + ((size_t)(b * 2 + j) * 256 + s) * 1024 + dcol;
                        *(f32x4*)(o) = (f32x4){v0[0], v0[1], v0[2], v0[3]}; *(f32x4*)(o + 4) = (f32x4){v0[4], v0[5], v0[6], v0[7]};
                        *(f32x4*)(o + 32) = (f32x4){v1[0], v1[1], v1[2], v1[3]}; *(f32x4*)(o + 36) = (f32x4){v1[4], v1[5], v1[6], v1[7]};
                    }
                }
            }
    }
};

struct EpiDownRaw {
    static constexpr bool PERM = true, AFTER_DRAIN = false;
    float* DOWN; EPI_NORMIN_DECL
    __device__ __forceinline__ void operator()(const pg8::f32x4 (&acc)[2][2][4][2], const pg8::Unit& u, int wr, int wc, int fr, int fq) const {
        const int row0 = u.pm * 256 + wr * 64 + fr, cb = u.pn * 256 + wc * 32 + 8 * fq;
        EPI_NORMIN_SW(sw, u, wc, fq);
        EPI_NORMIN_RSTD(rsv, row0);
#pragma unroll
        for (int ai = 0; ai < 2; ++ai)
#pragma unroll
            for (int m = 0; m < 4; ++m) {
                const int row = row0 + ai * 128 + m * 16;
                float* o = DOWN + (size_t)row * 1056;
                const float rstd = rsv[ai][m];
#pragma unroll
                for (int bj = 0; bj < 2; ++bj) { const int c = cb + bj * 128;
                    if (c < 1056) { EPI_VALS(v, ai, bj, m); EPI_NORMIN_APPLY(v, bj, rstd, sw);
                        *(f32x4*)(o + c) = (f32x4){v[0], v[1], v[2], v[3]}; *(f32x4*)(o + c + 4) = (f32x4){v[4], v[5], v[6], v[7]}; } }
            }
    }
};

struct EpiBf16Plain {
    static constexpr bool PERM = true, AFTER_DRAIN = false;
    bf16* O; int ldc;
    __device__ __forceinline__ void operator()(const pg8::f32x4 (&acc)[2][2][4][2], const pg8::Unit& u, int wr, int wc, int fr, int fq) const {
        const int row0 = u.pm * 256 + wr * 64 + fr, cb = u.pn * 256 + wc * 32 + 8 * fq;
#pragma unroll
        for (int ai = 0; ai < 2; ++ai)
#pragma unroll
            for (int m = 0; m < 4; ++m) {
                bf16* o = O + (size_t)(row0 + ai * 128 + m * 16) * ldc + cb;
#pragma unroll
                for (int bj = 0; bj < 2; ++bj) { EPI_VALS(v, ai, bj, m); *(u32x4*)(o + bj * 128) = pack8(v); }
            }
    }
};

struct EpiKVup {
    static constexpr bool PERM = true, AFTER_DRAIN = false;
    bf16* KM; bf16* VM; const float* kg; const float* KPE; const float* KPSS; const float* tabM;
    __device__ __forceinline__ void operator()(const pg8::f32x4 (&acc)[2][2][4][2], const pg8::Unit& u, int wr, int wc, int fr, int fq) const {
        const int row0 = u.pm * 256 + wr * 64 + fr;
        const int G = 4 * u.pn + wc, head = G >> 1, part = G & 1;
        const bool lat = u.pm >= 32 && u.pm < 40;
        float kps[2][4];
        if (part == 0) {
#pragma unroll
            for (int ai_ = 0; ai_ < 2; ++ai_)
#pragma unroll
                for (int m_ = 0; m_ < 4; ++m_) kps[ai_][m_] = KPSS[row0 + ai_ * 128 + m_ * 16];
        }
        float gain[2][8];
        if (part == 0) {
#pragma unroll
            for (int bj = 0; bj < 2; ++bj)
#pragma unroll
                for (int i = 0; i < 8; ++i) gain[bj][i] = kg[32 * bj + 8 * fq + i];
        }
#pragma unroll
        for (int ai = 0; ai < 2; ++ai)
#pragma unroll
            for (int m = 0; m < 4; ++m) {
                __builtin_amdgcn_sched_barrier(0);
                const int row = row0 + ai * 128 + m * 16;
                EPI_VALS(v0, ai, 0, m); EPI_VALS(v1, ai, 1, m);
                if (part == 0) {
                    float ss = 0.f;
#pragma unroll
                    for (int i = 0; i < 8; ++i) ss += v0[i] * v0[i] + v1[i] * v1[i];
                    ss = quad_sum(ss) + kps[ai][m];
                    const float rstd = __builtin_amdgcn_rsqf(ss * (1.f / 96.f) + EPS);
#pragma unroll
                    for (int i = 0; i < 8; ++i) { v0[i] = v0[i] * rstd * gain[0][i]; v1[i] = v1[i] * rstd * gain[1][i]; }
                    bf16* dst = KM + (size_t)row * 1536 + head * 96 + 8 * fq;
                    *(u32x4*)(dst) = pack8(v0); *(u32x4*)(dst + 32) = pack8(v1);
                    const float* kp = KPE + (size_t)row * 32;
                    const f32x4 a0 = *(const f32x4*)(kp + 8 * fq), a1 = *(const f32x4*)(kp + 8 * fq + 4);
                    float mine[8] = {a0.x * rstd, a0.y * rstd, a0.z * rstd, a0.w * rstd, a1.x * rstd, a1.y * rstd, a1.z * rstd, a1.w * rstd};
                    if (lat) {
                        const int t = (row - NCTX) & 1023, pos = (fq >> 1) ? (t & 63) : (t >> 6);
                        const float* tb = tabM + (size_t)pos * 16;
#pragma unroll
                        for (int i = 0; i < 8; ++i) { const float pp = __shfl_xor(mine[i], 16), c = tb[2 * i], s = tb[2 * i + 1];
                            mine[i] = (fq & 1) == 0 ? mine[i] * c - pp * s : mine[i] * c + pp * s; }
                    }
                    *(u32x4*)(KM + (size_t)row * 1536 + head * 96 + 64 + 8 * fq) = pack8(mine);
                } else {
                    bf16* dst = VM + (size_t)row * 1024 + head * 64 + 8 * fq;
                    *(u32x4*)(dst) = pack8(v0); *(u32x4*)(dst + 32) = pack8(v1);
                }
            }
    }
};

__device__ __forceinline__ int rowmap(int mode, int c) {
    if (mode == 1) { return c < DFF ? 256 * (c >> 7) + (c & 127) : 256 * ((c - DFF) >> 7) + 128 + ((c - DFF) & 127); }
    if (mode == 2) { const int G = c >> 6, e = c & 63; return 256 * (G >> 2) + 128 * (e >> 5) + 32 * (G & 3) + (e & 31); }
    return c;
}
__device__ __forceinline__ void xpose_item(const float* W, int K, int N, bf16* WT, int mode, LAS float* scr, int item, int lane, const float* sh = nullptr, float* shw = nullptr) {
    const int nblk = N / 32, kb = item / nblk, nb = item % nblk, k0 = 64 * kb, n0 = 32 * nb;
    {
        float wv[32];
        const float* wsrc = W + (size_t)(k0 + (lane >> 5)) * N + n0 + (lane & 31);
#pragma unroll
        for (int i = 0; i < 32; ++i) wv[i] = __builtin_nontemporal_load(wsrc + (size_t)(2 * i) * N);
#pragma unroll
        for (int i = 0; i < 32; ++i) scr[(2 * i + (lane >> 5)) * 33 + (lane & 31)] = wv[i];
    }
    asm volatile("s_waitcnt lgkmcnt(0)" ::: "memory");
    const int c = lane & 7, r0 = rowmap(mode, n0);
#pragma unroll
    for (int jj = 0; jj < 4; ++jj) { const int n = (lane >> 3) + 8 * jj; const LAS float* s = scr + (8 * c) * 33 + n;
        u32x4 o; o.x = pk2(s[0 * 33], s[1 * 33]); o.y = pk2(s[2 * 33], s[3 * 33]); o.z = pk2(s[4 * 33], s[5 * 33]); o.w = pk2(s[6 * 33], s[7 * 33]);
        __builtin_nontemporal_store(o, (u32x4*)(WT + (size_t)(r0 + n) * K + k0 + 8 * c)); }
    if (sh) {
        LAS float* s2 = scr + 64 * 33;
#pragma unroll
        for (int g = 0; g < 3; ++g) s2[g * 64 + lane] = sh[(size_t)g * NMOD + k0 + lane];
        asm volatile("s_waitcnt lgkmcnt(0)" ::: "memory");
        const int n = lane & 31, hf = lane >> 5;
        float a0 = 0.f, a1 = 0.f, a2 = 0.f;
#pragma unroll 8
        for (int kk = 0; kk < 32; ++kk) { const int k = hf * 32 + kk; const float w = scr[k * 33 + n]; a0 += w * s2[k]; a1 += w * s2[64 + k]; a2 += w * s2[128 + k]; }
        a0 += __shfl_xor(a0, 32); a1 += __shfl_xor(a1, 32); a2 += __shfl_xor(a2, 32);
        if (lane < 32) {
            __hip_atomic_fetch_add(shw + r0 + n, a0, __ATOMIC_RELAXED, __HIP_MEMORY_SCOPE_AGENT);
            __hip_atomic_fetch_add(shw + 5632 + r0 + n, a1, __ATOMIC_RELAXED, __HIP_MEMORY_SCOPE_AGENT);
            __hip_atomic_fetch_add(shw + 2 * 5632 + r0 + n, a2, __ATOMIC_RELAXED, __HIP_MEMORY_SCOPE_AGENT);
        }
    }
    asm volatile("s_waitcnt lgkmcnt(0)" ::: "memory");
}

constexpr int I_WIN = 16 * 176, I_WOUT = 44 * 32, I_DQKV = 16 * 96, I_WO = 16 * 32, I_MDOWN = 16 * 33, I_MQUP = 12 * 48, I_MKVUP = 4 * 64;
__device__ __forceinline__ int layer_items(int L) { return 2 * I_WIN + 2 * I_WOUT + ((L & 1) ? I_MDOWN + I_MQUP + I_MKVUP + I_WO : I_DQKV + I_WO); }
__device__ __forceinline__ void xpose_layer_item(int L, int r, LAS float* scr, int lane) {
    unsigned char* ws = ARGS.ws;
    const float* mod = (const float*)(ws + OFF_MOD); float* SHW = (float*)(ws + OFF_SHW);
    const int j = L >> 1;
    const float* shm = mod + (size_t)L * 3 * NMOD;
    if (r < 2 * I_WIN) { const int f = r / I_WIN, w = 2 * L + f, wh = 2 * f;
        xpose_item(ARGS.ffn_w_in + (size_t)w * DM * 2 * DFF, DM, 2 * DFF, (bf16*)(ws + OFF_WIN + w * SZ_WIN), 1, scr, r - f * I_WIN, lane, shm + (size_t)(3 * wh) * 1024, SHW + (size_t)(L * 3 + wh) * 3 * 5632); return; }
    r -= 2 * I_WIN;
    if (r < 2 * I_WOUT) { const int f = r / I_WOUT, w = 2 * L + f; xpose_item(ARGS.ffn_w_out + (size_t)w * DFF * DM, DFF, DM, (bf16*)(ws + OFF_WOUT + w * SZ_WOUT), 0, scr, r - f * I_WOUT, lane); return; }
    r -= 2 * I_WOUT;
    if ((L & 1) == 0) {
        if (r < I_DQKV) { xpose_item(ARGS.diff_w_qkv + (size_t)j * DM * 3072, DM, 3072, (bf16*)(ws + OFF_DQKV + j * SZ_DQKV), 2, scr, r, lane, shm + 3 * 1024, SHW + (size_t)(L * 3 + 1) * 3 * 5632); return; }
        r -= I_DQKV;
        xpose_item(ARGS.diff_w_o + (size_t)j * DM * DM, DM, DM, (bf16*)(ws + OFF_DWO + j * SZ_WO), 0, scr, r, lane);
    } else {
        if (r < I_MDOWN) { xpose_item(ARGS.mla_w_down + (size_t)j * DM * 1056, DM, 1056, (bf16*)(ws + OFF_MDOWN + j * SZ_MDOWN), 0, scr, r, lane, shm + 3 * 1024, SHW + (size_t)(L * 3 + 1) * 3 * 5632); return; }
        r -= I_MDOWN;
        if (r < I_MQUP) { xpose_item(ARGS.mla_w_q_up + (size_t)j * 768 * 1536, 768, 1536, (bf16*)(ws + OFF_MQUP + j * SZ_MQUP), 0, scr, r, lane); return; }
        r -= I_MQUP;
        if (r < I_MKVUP) { xpose_item(ARGS.mla_w_kv_up + (size_t)j * 256 * 2048, 256, 2048, (bf16*)(ws + OFF_MKVUP + j * SZ_MKVUP), 2, scr, r, lane); return; }
        r -= I_MKVUP;
        xpose_item(ARGS.mla_w_o + (size_t)j * DM * DM, DM, DM, (bf16*)(ws + OFF_MWO + j * SZ_WO), 0, scr, r, lane);
    }
}
constexpr int Q0_ITEMS = I_WOUT + I_DQKV + I_WO + I_WIN + I_WOUT;
constexpr int QUOTA_FFN_IN = 3456, QUOTA_FFN_OUT = 4608, QUOTA_OUT_PROJ = 2304, IDLE_FFN_IN = 880 - 768, IDLE_160 = 160;
__device__ __forceinline__ bool defer_ok() { return gridDim.x == 256; }
__device__ __forceinline__ void deferred_slot(LAS unsigned char* lds, int qpos, int quota, int idle0) {
    const int tid = opaque_tid(), lane = tid & 63, wave = __builtin_amdgcn_readfirstlane(tid >> 6);
    const int qtot = Q0_ITEMS + layer_items(1) + layer_items(2) + layer_items(3);
    const int qend = qpos + quota < qtot ? qpos + quota : qtot;
    const int nw = ((int)gridDim.x - idle0) * NWAVES, w = ((int)blockIdx.x - idle0) * NWAVES + wave;
    LAS float* scr = (LAS float*)(lds + wave * 16384);
    for (int q = qpos + w; q < qend; q += nw) {
        int L, r;
        if (q < Q0_ITEMS) { L = 0;
            if (q < I_WOUT) r = 2 * I_WIN + q;
            else if (q < I_WOUT + I_DQKV) r = 2 * I_WIN + 2 * I_WOUT + (q - I_WOUT);
            else if (q < I_WOUT + I_DQKV + I_WO) r = 2 * I_WIN + 2 * I_WOUT + I_DQKV + (q - I_WOUT - I_DQKV);
            else if (q < I_WOUT + I_DQKV + I_WO + I_WIN) r = I_WIN + (q - I_WOUT - I_DQKV - I_WO);
            else r = 2 * I_WIN + I_WOUT + (q - I_WOUT - I_DQKV - I_WO - I_WIN);
        } else { int qq = q - Q0_ITEMS; L = 1; if (qq >= layer_items(1)) { qq -= layer_items(1); L = 2; if (qq >= layer_items(2)) { qq -= layer_items(2); L = 3; } } r = qq; }
        xpose_layer_item(L, r, scr, lane);
    }
}

__device__ __forceinline__ void prologue(LAS unsigned char* lds, const int part) {
    const int tid = opaque_tid(), lane = tid & 63, wave = __builtin_amdgcn_readfirstlane(tid >> 6);
    unsigned char* ws = ARGS.ws;
    const int G = gridDim.x, bx = blockIdx.x;
    if (part == 0) {
        LAS float* sil = (LAS float*)lds;
        LAS float* red = (LAS float*)(lds + 12288);
        for (int i = tid; i < 3 * 1024; i += NTHREADS) { const int g = i >> 10, k = i & 1023; const float cv = g == 0 ? ARGS.c_ctx[k] : ARGS.c[(g - 1) * 1024 + k]; sil[i] = cv / (1.f + __expf(-cv)); }
        __syncthreads();
        float* mod = (float*)(ws + OFF_MOD);
        const int ln = lane < 36 ? lane : 35;
        for (int u = bx; u < 4 * 64; u += G) {
            const int l = u >> 6, n0 = (u & 63) * 144;
            const float* wp = ARGS.w_mod + ((size_t)l * 1024 + wave * 128) * NMOD + n0 + 4 * ln;
            f32x4 acc[3] = {{0.f, 0.f, 0.f, 0.f}, {0.f, 0.f, 0.f, 0.f}, {0.f, 0.f, 0.f, 0.f}};
#pragma unroll 1
            for (int kb = 0; kb < 128; kb += 16) {
                f32x4 w[16];
#pragma unroll
                for (int kk = 0; kk < 16; ++kk) w[kk] = *(const f32x4*)(wp + (size_t)(kb + kk) * NMOD);
#pragma unroll
                for (int kk = 0; kk < 16; ++kk) { const int k = wave * 128 + kb + kk;
#pragma unroll
                    for (int g = 0; g < 3; ++g) acc[g] += w[kk] * sil[g * 1024 + k]; }
            }
            if (lane < 36) {
#pragma unroll
                for (int g = 0; g < 3; ++g) *(LAS f32x4*)(red + (wave * 3 + g) * 144 + 4 * lane) = acc[g]; }
            __syncthreads();
            if (tid < 432) { const int g = tid / 144, cidx = tid - g * 144; float s = ARGS.b_mod[(size_t)l * NMOD + n0 + cidx];
#pragma unroll
                for (int w8 = 0; w8 < 8; ++w8) s += red[(w8 * 3 + g) * 144 + cidx];
                mod[((size_t)l * 3 + g) * NMOD + n0 + cidx] = s; }
            __syncthreads();
        }
    }
    if (part == 1) {
        LAS float* scr = (LAS float*)(lds + wave * 16384);
        const int gw = bx * NWAVES + wave, NGW = G * NWAVES;
        if (defer_ok()) { for (int r = gw; r < I_WIN; r += NGW) xpose_layer_item(0, r, scr, lane); }
        else for (int L = 0; L < 4; ++L) { const int n = layer_items(L);
            for (int r = gw; r < n; r += NGW) xpose_layer_item(L, r, scr, lane); }
    }
    if (part == 0) {
        const size_t gt = (size_t)bx * NTHREADS + tid, NT = (size_t)G * NTHREADS;
        for (size_t i = gt; i < (size_t)2 * 2 * 256 * 128; i += NT) {
            const int c8 = (int)(i & 127), s = (int)((i >> 7) & 255), j = (int)((i >> 15) & 1), b = (int)(i >> 16);
            const size_t src = (((size_t)(b * 2 + j) * 256 + s) * 1024) + c8 * 8, dst = (((size_t)j * 512 + b * 256 + s) * 1024) + c8 * 8;
            { const f32x4 a = *(const f32x4*)(ARGS.cache_diff_k + src), bb = *(const f32x4*)(ARGS.cache_diff_k + src + 4); float v[8] = {a.x, a.y, a.z, a.w, bb.x, bb.y, bb.z, bb.w}; *(u32x4*)((bf16*)(ws + OFF_KC) + dst) = pack8(v); }
            { const f32x4 a = *(const f32x4*)(ARGS.cache_diff_v + src), bb = *(const f32x4*)(ARGS.cache_diff_v + src + 4); float v[8] = {a.x, a.y, a.z, a.w, bb.x, bb.y, bb.z, bb.w}; *(u32x4*)((bf16*)(ws + OFF_VC) + dst) = pack8(v); }
        }
        for (size_t i = gt; i < (size_t)2 * 2 * 256 * 32; i += NT) {
            const int c8 = (int)(i & 31), s = (int)((i >> 5) & 255), j = (int)((i >> 13) & 1), b = (int)(i >> 14);
            const size_t src = (((size_t)(b * 2 + j) * 256 + s) * 256) + c8 * 8;
            const f32x4 a = *(const f32x4*)(ARGS.cache_mla_ckv + src), bb = *(const f32x4*)(ARGS.cache_mla_ckv + src + 4); float v[8] = {a.x, a.y, a.z, a.w, bb.x, bb.y, bb.z, bb.w};
            *(u32x4*)((bf16*)(ws + OFF_CKV + j * SZ_CKV) + ((size_t)(NTOK + b * 256 + s) * 256) + c8 * 8) = pack8(v);
        }
        for (size_t i = gt; i < (size_t)2 * 2 * 256; i += NT) {
            const int s = (int)(i & 255), j = (int)((i >> 8) & 1), b = (int)(i >> 9);
            const float* src = ARGS.cache_mla_kpe + ((size_t)(b * 2 + j) * 256 + s) * 32;
            float* dst = (float*)(ws + OFF_KPE + j * SZ_KPE) + (size_t)(NTOK + b * 256 + s) * 32;
            float ss = 0.f;
            for (int e = 0; e < 32; ++e) { const float v = src[e]; dst[e] = v * ARGS.mla_k_norm[j * 96 + 64 + e]; ss += v * v; }
            ((float*)(ws + OFF_KPSS + j * SZ_KPSS))[NTOK + b * 256 + s] = ss;
        }
        for (size_t i = gt; i < (size_t)2 * 224 * 128; i += NT) {
            const int c8 = (int)(i & 127), r = (int)((i >> 7) % 224), w = (int)(i / (224 * 128));
            *(u32x4*)((bf16*)(ws + OFF_MDOWN + w * SZ_MDOWN) + (size_t)(1056 + r) * 1024 + c8 * 8) = (u32x4){0u, 0u, 0u, 0u};
        }
        for (size_t i = gt; i < (size_t)12 * 3 * 5632 / 4; i += NT) *(f32x4*)((float*)(ws + OFF_SHW) + 4 * i) = (f32x4){0.f, 0.f, 0.f, 0.f};
        for (size_t i = gt; i < (size_t)12 * NTOK / 4; i += NT) *(f32x4*)((float*)(ws + OFF_SS) + 4 * i) = (f32x4){0.f, 0.f, 0.f, 0.f};
        for (size_t i = gt; i < 64 * 16 + 64 * 8; i += NT) {
            const bool isD = i < 64 * 16; const int idx = isD ? (int)i : (int)i - 64 * 16;
            const int pos = isD ? idx >> 4 : idx >> 3, f = isD ? idx & 15 : idx & 7;
            const float freq = __builtin_amdgcn_exp2f(-(isD ? (float)f / 16.f : (float)f / 8.f) * 13.287712379549449f);
            float rev = (float)pos * freq * 0.15915494309189535f; rev -= floorf(rev);
            const float cs = __builtin_amdgcn_cosf(rev), sn = __builtin_amdgcn_sinf(rev);
            float* tb = isD ? (float*)(ws + OFF_TABD) : (float*)(ws + OFF_TABM);
            tb[2 * idx] = cs; tb[2 * idx + 1] = sn;
        }
    }

    if (part == 1) {
        const float* mod = (const float*)(ws + OFF_MOD);
        const float* g = ARGS.norm_g; bf16* H = (bf16*)(ws + OFF_H); float* SS = (float*)(ws + OFF_SS);
        const int gw = bx * NWAVES + wave, NGW = G * NWAVES;
        constexpr int RB = 5;
        for (int row0 = gw; row0 < NTOK; row0 += RB * NGW) {
            f32x4 v[RB][4];
#pragma unroll
            for (int r = 0; r < RB; ++r) { const int row = row0 + r * NGW < NTOK ? row0 + r * NGW : gw;
                const float* xr = row < NCTX ? ARGS.x_prompt + (size_t)row * DM : ARGS.x_sample + (size_t)(row - NCTX) * DM;
#pragma unroll
                for (int jj = 0; jj < 4; ++jj) v[r][jj] = *(const f32x4*)(xr + 4 * lane + 256 * jj); }
#pragma unroll
            for (int r = 0; r < RB; ++r) { const int row = row0 + r * NGW;
                if (row < NTOK) {
                    const float* md = mod + (size_t)tok_group(row) * NMOD + 1024;
                    float ss = 0.f;
#pragma unroll
                    for (int jj = 0; jj < 4; ++jj) { const int c = 4 * lane + 256 * jj; const f32x4 x4 = v[r][jj], gg = *(const f32x4*)(g + c), sc = *(const f32x4*)(md + c);
                        ss += x4.x * x4.x + x4.y * x4.y + x4.z * x4.z + x4.w * x4.w;
                        *(u32x2*)(H + (size_t)row * DM + c) = (u32x2){pk2(x4.x * gg.x * (1.f + sc.x), x4.y * gg.y * (1.f + sc.y)), pk2(x4.z * gg.z * (1.f + sc.z), x4.w * gg.w * (1.f + sc.w))}; }
                    ss = wave_sum(ss);
                    if (lane == 0) SS[row] = ss;
                }
            }
        }
    }
}

__device__ __forceinline__ void init_phase(LAS unsigned char* lds) {
    const int tid = opaque_tid(), lane = tid & 63, wave = __builtin_amdgcn_readfirstlane(tid >> 6);
    unsigned char* ws = ARGS.ws;
    const float* mod = (const float*)(ws + OFF_MOD);
    const int gw = blockIdx.x * NWAVES + wave, NGW = gridDim.x * NWAVES;
    {
        const float* g = ARGS.norm_g; bf16* H = (bf16*)(ws + OFF_H); float* SS = (float*)(ws + OFF_SS);
        for (int row = gw; row < NTOK; row += NGW) {
            const float* xr = row < NCTX ? ARGS.x_prompt + (size_t)row * DM : ARGS.x_sample + (size_t)(row - NCTX) * DM;
            const float* md = mod + (size_t)tok_group(row) * NMOD + 1024;
            float ss = 0.f;
#pragma unroll
            for (int jj = 0; jj < 4; ++jj) { const int c = 4 * lane + 256 * jj; const f32x4 v = *(const f32x4*)(xr + c), gg = *(const f32x4*)(g + c), sc = *(const f32x4*)(md + c);
                ss += v.x * v.x + v.y * v.y + v.z * v.z + v.w * v.w;
                *(u32x2*)(H + (size_t)row * DM + c) = (u32x2){pk2(v.x * gg.x * (1.f + sc.x), v.y * gg.y * (1.f + sc.y)), pk2(v.z * gg.z * (1.f + sc.z), v.w * gg.w * (1.f + sc.w))}; }
            ss = wave_sum(ss);
            if (lane == 0) SS[row] = ss;
        }
    }
    {
        float* SHW = (float*)(ws + OFF_SHW);
        for (int l = 0; l < 4; ++l) {
            const int j = l >> 1, NM = (l & 1) ? 1280 : 3072, tot = 2 * 5632 + NM;
            for (int r = gw; r < tot; r += NGW) {
                int which, n; const bf16* Bt;
                if (r < 5632) { which = 0; n = r; Bt = (const bf16*)(ws + OFF_WIN + (size_t)(l * 2) * SZ_WIN); }
                else if (r < 2 * 5632) { which = 2; n = r - 5632; Bt = (const bf16*)(ws + OFF_WIN + (size_t)(l * 2 + 1) * SZ_WIN); }
                else { which = 1; n = r - 2 * 5632; Bt = (l & 1) ? (const bf16*)(ws + OFF_MDOWN + j * SZ_MDOWN) : (const bf16*)(ws + OFF_DQKV + j * SZ_DQKV); }
                const bf16* wr_ = Bt + (size_t)n * DM;
                const bf16x8 w0 = *(const bf16x8*)(wr_ + 8 * lane), w1 = *(const bf16x8*)(wr_ + 512 + 8 * lane);
                const float* sh = mod + (size_t)l * 3 * NMOD + (size_t)(3 * which) * 1024;
                float a[3];
#pragma unroll
                for (int g = 0; g < 3; ++g) { const float* s = sh + (size_t)g * NMOD; float acc = 0.f;
                    const f32x4 s0 = *(const f32x4*)(s + 8 * lane), s1 = *(const f32x4*)(s + 8 * lane + 4), s2 = *(const f32x4*)(s + 512 + 8 * lane), s3 = *(const f32x4*)(s + 512 + 8 * lane + 4);
                    acc += bf2f((unsigned short)w0[0]) * s0.x + bf2f((unsigned short)w0[1]) * s0.y + bf2f((unsigned short)w0[2]) * s0.z + bf2f((unsigned short)w0[3]) * s0.w;
                    acc += bf2f((unsigned short)w0[4]) * s1.x + bf2f((unsigned short)w0[5]) * s1.y + bf2f((unsigned short)w0[6]) * s1.z + bf2f((unsigned short)w0[7]) * s1.w;
                    acc += bf2f((unsigned short)w1[0]) * s2.x + bf2f((unsigned short)w1[1]) * s2.y + bf2f((unsigned short)w1[2]) * s2.z + bf2f((unsigned short)w1[3]) * s2.w;
                    acc += bf2f((unsigned short)w1[4]) * s3.x + bf2f((unsigned short)w1[5]) * s3.y + bf2f((unsigned short)w1[6]) * s3.z + bf2f((unsigned short)w1[7]) * s3.w;
                    a[g] = wave_sum(acc); }
                if (lane < 3) SHW[((size_t)(l * 3 + which) * 3 + lane) * 5632 + n] = lane == 0 ? a[0] : (lane == 1 ? a[1] : a[2]);
            }
        }
    }
}
__device__ __forceinline__ void mla_norm_phase(int j) {
    const int tid = opaque_tid(), lane = tid & 63, wave = __builtin_amdgcn_readfirstlane(tid >> 6);
    unsigned char* ws = ARGS.ws;
    const float* DOWN = (const float*)(ws + OFF_DOWN); bf16* CQ = (bf16*)(ws + OFF_CQ); bf16* CKV = (bf16*)(ws + OFF_CKV + j * SZ_CKV);
    float* KPE = (float*)(ws + OFF_KPE + j * SZ_KPE); float* KPSS = (float*)(ws + OFF_KPSS + j * SZ_KPSS);
    const float* qag = ARGS.mla_q_a_norm + j * 768; const float* kvag = ARGS.mla_kv_a_norm + j * 256;
    const int gw = blockIdx.x * NWAVES + wave, NGW = gridDim.x * NWAVES;
    const f32x4 kg4 = *(const f32x4*)(kvag + 4 * lane);
    const float kpg = lane < 32 ? ARGS.mla_k_norm[j * 96 + 64 + lane] : 0.f;
    f32x4 qg4[3];
#pragma unroll
    for (int jj = 0; jj < 3; ++jj) qg4[jj] = *(const f32x4*)(qag + 4 * lane + 256 * jj);
    constexpr int RB = 5;
    for (int row0 = gw; row0 < NTOK; row0 += RB * NGW) {
        f32x4 v[RB][3], kv[RB]; float pe[RB];
#pragma unroll
        for (int r = 0; r < RB; ++r) { const int row = row0 + r * NGW; const float* dr = DOWN + (size_t)(row < NTOK ? row : gw) * 1056;
#pragma unroll
            for (int jj = 0; jj < 3; ++jj) v[r][jj] = *(const f32x4*)(dr + 4 * lane + 256 * jj);
            kv[r] = *(const f32x4*)(dr + 768 + 4 * lane);
            pe[r] = lane < 32 ? dr[1024 + lane] : 0.f; }
#pragma unroll
        for (int r = 0; r < RB; ++r) { const int row = row0 + r * NGW;
            if (row < NTOK) {
                float ss = 0.f;
#pragma unroll
                for (int jj = 0; jj < 3; ++jj) ss += v[r][jj].x * v[r][jj].x + v[r][jj].y * v[r][jj].y + v[r][jj].z * v[r][jj].z + v[r][jj].w * v[r][jj].w;
                const float rq = __builtin_amdgcn_rsqf(wave_sum(ss) * (1.f / 768.f) + EPS);
#pragma unroll
                for (int jj = 0; jj < 3; ++jj) { const int c = 4 * lane + 256 * jj; const f32x4 gg = qg4[jj];
                    *(u32x2*)(CQ + (size_t)row * 768 + c) = (u32x2){pk2(v[r][jj].x * rq * gg.x, v[r][jj].y * rq * gg.y), pk2(v[r][jj].z * rq * gg.z, v[r][jj].w * rq * gg.w)}; }
                const f32x4 k4 = kv[r];
                const float rk = __builtin_amdgcn_rsqf(wave_sum(k4.x * k4.x + k4.y * k4.y + k4.z * k4.z + k4.w * k4.w) * (1.f / 256.f) + EPS);
                const f32x4 kn = (f32x4){k4.x * rk * kg4.x, k4.y * rk * kg4.y, k4.z * rk * kg4.z, k4.w * rk * kg4.w};
                *(u32x2*)(CKV + (size_t)row * 256 + 4 * lane) = (u32x2){pk2(kn.x, kn.y), pk2(kn.z, kn.w)};
                const float pss = wave_sum(pe[r] * pe[r]);
                if (lane < 32) KPE[(size_t)row * 32 + lane] = pe[r] * kpg;
                if (lane == 0) KPSS[row] = pss;
                if (row < NCTX) { const int b = row >> 8, s = row & 255;
                    *(f32x4*)(ARGS.out + OUT_CKV + ((size_t)(b * 2 + j) * 256 + s) * 256 + 4 * lane) = kn;
                    if (lane < 32) ARGS.out[OUT_KPE + ((size_t)(b * 2 + j) * 256 + s) * 32 + lane] = pe[r]; }
            }
        }
    }
}

struct AttnArgs {
    const bf16* Q; int qpitch;
    const bf16* K; int kpitch;
    const bf16* V; int vpitch;
    const bf16* Kc; const bf16* Vc;
    bf16* O;
    const float* qg;
    const float* tabM;
    const float* subln;
    float lam, one_m_lam_init, scale_log2;
    unsigned* ctr;
    int nheads;
};

template <int NC, int DK, int DV, bool MLA, int QT>
__device__ __forceinline__ void attn_phase(LAS unsigned char* lds, const AttnArgs& a) {
    const int tid = opaque_tid(), lane = tid & 63, wave = __builtin_amdgcn_readfirstlane(tid >> 6);
    constexpr int KB = NC * DK * 2, VB = DV * 2;
    constexpr int KP = 272, VP = 288;
    constexpr bool VSWZ = true;
    constexpr int KPR = KB / 16, VPR = VB / 16, NPIECE = 64 * (KPR + VPR), NST = (NPIECE + NTHREADS - 1) / NTHREADS;
    constexpr int KS = DK / 32, DC = DV / 16;
    LAS unsigned char* ldsK = lds; LAS unsigned char* ldsV = lds + 64 * KP;
    volatile LAS int* uslot = (volatile LAS int*)(lds + 64 * KP + 64 * VP);
    const int fr = lane & 15, g = lane >> 4;
    constexpr int LQB = 8 / QT, CQB = 2 / QT;
    const int nlat = 2 * a.nheads * LQB, nctx = 32 * a.nheads * CQB, nunits = nlat + nctx;
    const bool stat = (gridDim.x == 256) && nlat == 128 && nctx == 512;
    for (int it = 0;; ++it) {
        int u;
        if (stat) { const int bxs = (int)blockIdx.x; u = bxs < 128 ? (it == 0 ? bxs : nunits) : (it < 4 ? 128 + 4 * (bxs - 128) + it : nunits); }
        else {
            __syncthreads();
            if (tid == 0) *uslot = (int)atomicAdd(a.ctr, 1u);
            __syncthreads();
            u = *uslot;
        }
        if (u >= nunits) break;
        int b, h, qb, nch, qrow0; const bf16 *kc0, *vc0, *kn0, *vn0; bool lat;
        if (u < nlat) { lat = true; b = u / (a.nheads * LQB); const int r = u % (a.nheads * LQB); h = r / LQB; qb = r % LQB; nch = 20; qrow0 = NCTX + b * 1024 + qb * 128 * QT;
            kc0 = a.Kc + (size_t)(b * 256) * a.kpitch; vc0 = a.Vc + (size_t)(b * 256) * a.vpitch; kn0 = a.K + (size_t)(NCTX + b * 1024) * a.kpitch; vn0 = a.V + (size_t)(NCTX + b * 1024) * a.vpitch; }
        else { lat = false; const int uu = u - nlat; b = uu / (a.nheads * CQB); const int r = uu % (a.nheads * CQB); h = r / CQB; qb = r % CQB; nch = 4; qrow0 = b * 256 + qb * 128 * QT;
            kc0 = a.K + (size_t)(b * 256) * a.kpitch; vc0 = a.V + (size_t)(b * 256) * a.vpitch; kn0 = kc0; vn0 = vc0; }
        bf16x8 qf[QT][NC][KS];
#pragma unroll
        for (int qt = 0; qt < QT; ++qt) {
        const int qrow = qrow0 + wave * 16 * QT + qt * 16 + fr;
        if constexpr (!MLA) {
#pragma unroll
            for (int c = 0; c < NC; ++c)
#pragma unroll
                for (int ks = 0; ks < KS; ++ks) qf[qt][c][ks] = *(const bf16x8*)(a.Q + (size_t)qrow * a.qpitch + (h * NC + c) * DK + 32 * ks + 8 * g);
        } else {
            float x[KS][8]; float ss = 0.f;
#pragma unroll
            for (int ks = 0; ks < KS; ++ks) { const bf16x8 raw = *(const bf16x8*)(a.Q + (size_t)qrow * a.qpitch + h * DK + 32 * ks + 8 * g);
#pragma unroll
                for (int i = 0; i < 8; ++i) { x[ks][i] = bf2f((unsigned short)raw[i]); ss += x[ks][i] * x[ks][i]; } }
            ss = quad_sum(ss);
            const float rstd = __builtin_amdgcn_rsqf(ss * (1.f / DK) + EPS);
#pragma unroll
            for (int ks = 0; ks < KS; ++ks)
#pragma unroll
                for (int i = 0; i < 8; ++i) x[ks][i] = x[ks][i] * rstd * a.qg[32 * ks + 8 * g + i];
            if (lat) {
                const int t = (qrow - NCTX) & 1023, pos = (g >> 1) ? (t & 63) : (t >> 6);
                const float* tb = a.tabM + (size_t)pos * 16;
#pragma unroll
                for (int i = 0; i < 8; ++i) { const float p = __shfl_xor(x[KS - 1][i], 16), cs = tb[2 * i], sn = tb[2 * i + 1];
                    x[KS - 1][i] = (g & 1) == 0 ? x[KS - 1][i] * cs - p * sn : x[KS - 1][i] * cs + p * sn; }
            }
#pragma unroll
            for (int ks = 0; ks < KS; ++ks) qf[qt][0][ks] = __builtin_bit_cast(bf16x8, pack8(x[ks]));
        }
        }
        float mrun[QT][NC], lrun[QT][NC]; f32x4 o[QT][NC][DC];
#pragma unroll
        for (int qt = 0; qt < QT; ++qt)
#pragma unroll
        for (int c = 0; c < NC; ++c) { mrun[qt][c] = -1e30f; lrun[qt][c] = 0.f;
#pragma unroll
            for (int dc = 0; dc < DC; ++dc) o[qt][c][dc] = (f32x4){0.f, 0.f, 0.f, 0.f}; }
        constexpr int NKP = 64 * KPR, NVP = 64 * VPR, NKL = (NKP + NTHREADS - 1) / NTHREADS, NVL = NVP / NTHREADS;
        static_assert(NVP % NTHREADS == 0 && NKL * NTHREADS <= 2 * NKP, "staging piece map");
        constexpr int DEPTH = MLA ? 4 : 2;
        u32x4 st[DEPTH][NKL + NVL];
        const int kcol = h * NC * DK, vcol = h * DV;
#define ATT_PREFETCH(ch, SB) do { const int key0 = (ch) * 64; const bf16* kb_ = key0 < 256 ? kc0 + (size_t)key0 * a.kpitch : kn0 + (size_t)(key0 - 256) * a.kpitch; \
            const bf16* vb_ = key0 < 256 ? vc0 + (size_t)key0 * a.vpitch : vn0 + (size_t)(key0 - 256) * a.vpitch; \
            _Pragma("unroll") for (int s_ = 0; s_ < NKL; ++s_) { const int p0_ = tid + s_ * NTHREADS, p_ = p0_ < NKP ? p0_ : p0_ - NKP; const int r_ = p_ / KPR, c_ = p_ % KPR; \
                st[SB][s_] = *(const u32x4*)(kb_ + (size_t)r_ * a.kpitch + kcol + c_ * 8); } \
            _Pragma("unroll") for (int s_ = 0; s_ < NVL; ++s_) { const int q_ = tid + s_ * NTHREADS, r_ = q_ / VPR, c_ = q_ % VPR; \
                st[SB][NKL + s_] = *(const u32x4*)(vb_ + (size_t)r_ * a.vpitch + vcol + c_ * 8); } } while (0)
#define ATT_COMMIT(SB) do { \
            _Pragma("unroll") for (int s_ = 0; s_ < NKL; ++s_) { const int p0_ = tid + s_ * NTHREADS, p_ = p0_ < NKP ? p0_ : p0_ - NKP; const int r_ = p_ / KPR, c_ = p_ % KPR; \
                *(LAS u32x4*)(ldsK + r_ * KP + (c_ ^ (((r_ >> 4) & 1) << 2)) * 16) = st[SB][s_]; } \
            _Pragma("unroll") for (int s_ = 0; s_ < NVL; ++s_) { const int q_ = tid + s_ * NTHREADS, r_ = q_ / VPR, c_ = q_ % VPR; \
                *(LAS u32x4*)(ldsV + r_ * VP + (VSWZ ? (c_ ^ (((r_ >> 3) & 1) << 3)) : c_) * 16) = st[SB][NKL + s_]; } } while (0)
#pragma unroll
        for (int hb = 0; hb < DEPTH; ++hb) ATT_PREFETCH(hb, hb);
        for (int ch2 = 0; ch2 < nch; ch2 += DEPTH) {
#pragma unroll
          for (int hb = 0; hb < DEPTH; ++hb) {
            const int ch = ch2 + hb;
            __syncthreads();
            ATT_COMMIT(hb);
            __syncthreads();
            { const int chp = ch + DEPTH < nch ? ch + DEPTH : nch - 1;
              ATT_PREFETCH(chp, hb); }
            bf16x8 pb[QT][NC][2];
#pragma unroll
            for (int c = 0; c < NC; ++c) {
                f32x4 sq[QT][4];
#pragma unroll
                for (int kt = 0; kt < 4; ++kt) {
#pragma unroll
                    for (int qt = 0; qt < QT; ++qt) sq[qt][kt] = (f32x4){0.f, 0.f, 0.f, 0.f};
                    const int keyrow = 32 * (kt >> 1) + 8 * (fr >> 2) + 4 * (kt & 1) + (fr & 3);
#pragma unroll
                    for (int ks = 0; ks < KS; ++ks) { const bf16x8 kf = *(const LAS bf16x8*)(ldsK + keyrow * KP + (((c * DK * 2 + ks * 64) / 16 + g) ^ (((fr >> 3) & 1) << 2)) * 16);
#pragma unroll
                        for (int qt = 0; qt < QT; ++qt) sq[qt][kt] = __builtin_amdgcn_mfma_f32_16x16x32_bf16(kf, qf[qt][c][ks], sq[qt][kt], 0, 0, 0); }
                }
#pragma unroll
                for (int qt = 0; qt < QT; ++qt) {
                f32x4 (&s)[4] = sq[qt];
                float mx = -1e30f;
#pragma unroll
                for (int kt = 0; kt < 4; ++kt) mx = fmaxf(mx, fmaxf(fmaxf(s[kt].x, s[kt].y), fmaxf(s[kt].z, s[kt].w)));
                mx = quad_max(mx) * a.scale_log2;
                const bool need = mx > mrun[qt][c] + 8.f;
                if (__builtin_amdgcn_ballot_w64(need) != 0ull) {
                    const float mnew = need ? mx : mrun[qt][c], alpha = __builtin_amdgcn_exp2f(mrun[qt][c] - mnew);
                    lrun[qt][c] *= alpha; mrun[qt][c] = mnew;
#pragma unroll
                    for (int dc = 0; dc < DC; ++dc) o[qt][c][dc] = o[qt][c][dc] * alpha;
                }
                const float nm = -mrun[qt][c], sc2 = a.scale_log2;
                float rs = 0.f;
#pragma unroll
                for (int kt = 0; kt < 4; ++kt) { s[kt].x = __builtin_amdgcn_exp2f(__builtin_fmaf(s[kt].x, sc2, nm)); s[kt].y = __builtin_amdgcn_exp2f(__builtin_fmaf(s[kt].y, sc2, nm));
                    s[kt].z = __builtin_amdgcn_exp2f(__builtin_fmaf(s[kt].z, sc2, nm)); s[kt].w = __builtin_amdgcn_exp2f(__builtin_fmaf(s[kt].w, sc2, nm));
                    rs += (s[kt].x + s[kt].y) + (s[kt].z + s[kt].w); }
                rs = quad_sum(rs);
                lrun[qt][c] += rs;
#pragma unroll
                for (int t = 0; t < 2; ++t) { u32x4 w; w.x = pk2(s[2 * t].x, s[2 * t].y); w.y = pk2(s[2 * t].z, s[2 * t].w); w.z = pk2(s[2 * t + 1].x, s[2 * t + 1].y); w.w = pk2(s[2 * t + 1].z, s[2 * t + 1].w);
                    pb[qt][c][t] = __builtin_bit_cast(bf16x8, w); }
                }
            }
#pragma unroll
            for (int t = 0; t < 2; ++t) { __builtin_amdgcn_sched_barrier(0);
#pragma unroll
                for (int dc = 0; dc < DC; ++dc) {
                    const int vslot = 2 * dc + ((fr & 3) >> 1);
                    const LAS unsigned char* vp = ldsV + (32 * t + 8 * g + (fr >> 2)) * VP + (VSWZ ? (vslot ^ ((g & 1) << 3)) : vslot) * 16 + (fr & 1) * 8;
                    const s16x4 lo = __builtin_bit_cast(s16x4, __builtin_amdgcn_ds_read_tr16_b64_v4i16((LAS s16x4*)vp));
                    const s16x4 hi = __builtin_bit_cast(s16x4, __builtin_amdgcn_ds_read_tr16_b64_v4i16((LAS s16x4*)(vp + 4 * VP)));
                    bf16x8 vf; vf[0] = lo[0]; vf[1] = lo[1]; vf[2] = lo[2]; vf[3] = lo[3]; vf[4] = hi[0]; vf[5] = hi[1]; vf[6] = hi[2]; vf[7] = hi[3];
#pragma unroll
                    for (int qt = 0; qt < QT; ++qt)
#pragma unroll
                    for (int c = 0; c < NC; ++c) o[qt][c][dc] = __builtin_amdgcn_mfma_f32_16x16x32_bf16(vf, pb[qt][c][t], o[qt][c][dc], 0, 0, 0);
                } }
          }
        }
#undef ATT_PREFETCH
#undef ATT_COMMIT
#pragma unroll
        for (int qt = 0; qt < QT; ++qt) {
        const int qrow = qrow0 + wave * 16 * QT + qt * 16 + fr;
        bf16* orow = a.O + (size_t)qrow * 1024 + h * DV + 4 * g;
        if constexpr (!MLA) {
            const float i0 = __builtin_amdgcn_rcpf(lrun[qt][0]), i1 = a.lam * __builtin_amdgcn_rcpf(lrun[qt][NC - 1]);
            float ss = 0.f;
#pragma unroll
            for (int dc = 0; dc < DC; ++dc) { o[qt][0][dc] = o[qt][0][dc] * i0 - o[qt][NC - 1][dc] * i1; ss += o[qt][0][dc].x * o[qt][0][dc].x + o[qt][0][dc].y * o[qt][0][dc].y + o[qt][0][dc].z * o[qt][0][dc].z + o[qt][0][dc].w * o[qt][0][dc].w; }
            ss = quad_sum(ss);
            const float rstd = __builtin_amdgcn_rsqf(ss * (1.f / DV) + EPS) * a.one_m_lam_init;
#pragma unroll
            for (int dc = 0; dc < DC; ++dc) { const f32x4 sg = *(const f32x4*)(a.subln + 16 * dc + 4 * g);
                *(u32x2*)(orow + 16 * dc) = (u32x2){pk2(o[qt][0][dc].x * rstd * sg.x, o[qt][0][dc].y * rstd * sg.y), pk2(o[qt][0][dc].z * rstd * sg.z, o[qt][0][dc].w * rstd * sg.w)}; }
        } else {
            const float i0 = __builtin_amdgcn_rcpf(lrun[qt][0]);
#pragma unroll
            for (int dc = 0; dc < DC; ++dc) *(u32x2*)(orow + 16 * dc) = (u32x2){pk2(o[qt][0][dc].x * i0, o[qt][0][dc].y * i0), pk2(o[qt][0][dc].z * i0, o[qt][0][dc].w * i0)};
        }
        }
    }
}

#define XB_TMO      128
#define XB_XCNT(j)  (256  + 64 * (j))
#define XB_XSUB(j)  (1280 + 64 * (j))
#define XB_XGEN(j)  (2304 + 64 * (j))
#define XB_TOP      3328
#define XB_TOPGEN   3392
#define XCD_BAR_WORDS 3456
#define XB_SPIN_CAP (1u << 18)

__device__ __forceinline__ unsigned xb_ld(unsigned* p)              { return __hip_atomic_load(p, __ATOMIC_RELAXED, __HIP_MEMORY_SCOPE_AGENT); }
__device__ __forceinline__ unsigned xb_add(unsigned* p, unsigned v) { return __hip_atomic_fetch_add(p, v, __ATOMIC_RELAXED, __HIP_MEMORY_SCOPE_AGENT); }
__device__ __forceinline__ unsigned xb_xcc_id() { return (unsigned)__builtin_amdgcn_s_getreg((3 << 11) | 20) & 0xFu; }
#define XB_SPIN(cond, bar) do { unsigned _sp = 0; while (cond) { __builtin_amdgcn_s_sleep(1); \
    if ((++_sp & 255u) == 0u) { if (xb_ld(&(bar)[XB_TMO])) break; if (_sp > XB_SPIN_CAP) { atomicAdd(&(bar)[XB_TMO], 1u); break; } } } } while (0)

struct XcdBarrier {
    unsigned* bar; unsigned x;
    volatile LAS unsigned* st;
};

__device__ __forceinline__ XcdBarrier xcd_barrier_post(unsigned* bar, volatile LAS unsigned* st) {
    XcdBarrier b; b.bar = bar; b.x = xb_xcc_id(); b.st = st;
    if (threadIdx.x == 0) (void)xb_add(&bar[XB_XCNT(b.x)], 1u);
    return b;
}
__device__ __forceinline__ void xcd_barrier_complete(unsigned* bar, unsigned x, unsigned& nloc, unsigned& nx) {
    const unsigned G = gridDim.x * gridDim.y * gridDim.z;
    unsigned sum, cnt, mine, sp = 0u;
    for (;;) {
        sum = 0u; cnt = 0u; mine = 0u;
#pragma unroll
        for (unsigned j = 0; j < 16; ++j) { const unsigned c = xb_ld(&bar[XB_XCNT(j)]); sum += c; cnt += (c > 0u) ? 1u : 0u; mine = (j == x) ? c : mine; }
        if (sum == G) break;
        __builtin_amdgcn_s_sleep(1);
        if ((++sp & 255u) == 0u) { if (xb_ld(&bar[XB_TMO])) break; if (sp > XB_SPIN_CAP) { atomicAdd(&bar[XB_TMO], 1u); break; } }
    }
    nloc = mine > 0u ? mine : 1u; nx = cnt > 0u ? cnt : 1u;
}

__device__ __forceinline__ void xcd_barrier(const XcdBarrier& b) {
    asm volatile("s_waitcnt vmcnt(0)" ::: "memory");
    __syncthreads();
    if (threadIdx.x == 0) {
        unsigned* bar = b.bar;
        __builtin_amdgcn_s_waitcnt(0);
        unsigned nloc = b.st[0], nx = b.st[1];
        if (nloc == 0u) { xcd_barrier_complete(bar, b.x, nloc, nx); b.st[0] = nloc; b.st[1] = nx; }
        const unsigned old = xb_add(&bar[XB_XSUB(b.x)], 1u);
        const unsigned gen = old / nloc;
        if (old + 1u == (gen + 1u) * nloc) {
            __builtin_amdgcn_fence(__ATOMIC_RELEASE, "agent");
            asm volatile("s_waitcnt vmcnt(0)" ::: "memory");
            const unsigned og = xb_add(&bar[XB_TOP], 1u);
            const unsigned tg = og / nx;
            if (og + 1u == (tg + 1u) * nx) xb_add(&bar[XB_TOPGEN], 1u);
            else XB_SPIN(xb_ld(&bar[XB_TOPGEN]) == tg, bar);
            __builtin_amdgcn_fence(__ATOMIC_ACQUIRE, "agent");
            xb_add(&bar[XB_XGEN(b.x)], 1u);
            asm volatile("s_waitcnt vmcnt(0)" ::: "memory");
        } else {
            asm volatile("buffer_inv sc1" ::: "memory");
            XB_SPIN(xb_ld(&bar[XB_XGEN(b.x)]) == gen, bar);
            asm volatile("" ::: "memory");
            asm volatile("s_waitcnt vmcnt(0)" ::: "memory");
        }
    }
    __syncthreads();
}

__global__ void __launch_bounds__(NTHREADS, 2) mega_fwd(Args A_kernarg) {
    extern __shared__ __attribute__((aligned(16))) unsigned char lds_raw[];
    LAS unsigned char* lds = (LAS unsigned char*)lds_raw;
    cg::grid_group grid = cg::this_grid();
    { const int t0 = threadIdx.x; if (t0 < 64) ((LAS unsigned*)(lds + 131072))[t0] = 0u; }
    __syncthreads();
    (void)xcd_barrier_post((unsigned*)(ARGS.ws + OFF_CTL) + 4096, (volatile LAS unsigned*)(lds + 131072 + 32));
#define GSYNC1() do { XcdBarrier b_; b_.bar = (unsigned*)(ws + OFF_CTL) + 4096; b_.x = xb_xcc_id(); b_.st = (volatile LAS unsigned*)(lds + 131072 + 32); xcd_barrier(b_); } while (0)
#ifdef PROBE_SYNC
#define GSYNC() do { GSYNC1(); GSYNC1(); } while (0)
#else
#define GSYNC() GSYNC1()
#endif
    const int G = gridDim.x, bx = blockIdx.x;
    int qpos = 0;
#define ws (ARGS.ws)
#define out (ARGS.out)
#define mod ((const float*)(ws + OFF_MOD))
#define H ((bf16*)(ws + OFF_H))
#define ACT ((bf16*)(ws + OFF_ACT))
#define QB ((bf16*)(ws + OFF_Q))
#define KBUF ((bf16*)(ws + OFF_K))
#define VBUF ((bf16*)(ws + OFF_V))
#define OB ((bf16*)(ws + OFF_O))
#define ctl ((unsigned*)(ws + OFF_CTL))
#define SSLOT(s) ((float*)(ws + OFF_SS) + (size_t)(s) * NTOK)
#define SHWSLOT(s) ((const float*)(ws + OFF_SHW) + (size_t)(s) * 3 * 5632)


    prologue(lds, 0);
    if (out == nullptr) grid.sync();
    GSYNC();
    prologue(lds, 1);
    GSYNC();

#pragma unroll 1
    for (int l = 0; l < 4; ++l) {
        const int j = l >> 1;
#define modl (mod + (size_t)l * 3 * NMOD)
#define xp (l == 0 ? ARGS.x_prompt : (const float*)out)
#define xs (l == 0 ? ARGS.x_sample : (const float*)(out + (size_t)NCTX * DM))
#define xso (out + (size_t)NCTX * DM)
#pragma unroll 1
        for (int f = 0; f < 2; ++f) {
            if (f == 1) {
                if ((l & 1) == 0) {
                    { pg8::Gemm gm{H, (const bf16*)(ws + OFF_DQKV + j * SZ_DQKV), NTOK, 3072, DM}; pg8::StaticOrder S; S.init(NTOK, 3072, G, bx);
                      EpiDiffQKV E{QB, KBUF, VBUF, ARGS.diff_q_norm + j * 64, ARGS.diff_k_norm + j * 64, (const float*)(ws + OFF_TABD), out + OUT_DK, out + OUT_DV, j, SSLOT(l * 3 + 1), SHWSLOT(l * 3 + 1)};

#if !defined(ONLY) || ONLY == 1
      pg8::gemm_phase<EpiDiffQKV, pg8::StaticOrder, true, true>(lds, gm, S, E);
#endif
 }
                    GSYNC();
                    { const float* lp = ARGS.diff_lambda + j * 256; const int lane = opaque_tid() & 63;
                      const float s1 = wave_sum(lp[lane] * lp[64 + lane]), s2 = wave_sum(lp[128 + lane] * lp[192 + lane]);
                      int l_o = l; asm volatile("" : "+s"(l_o)); const float lam_init = l_o == 0 ? 0.2f : 0.47071301834358418f;
                      const float lam = __expf(s1) - __expf(s2) + lam_init;
                      AttnArgs a{QB, 1024, KBUF, 1024, VBUF, 1024, (const bf16*)(ws + OFF_KC) + (size_t)j * 512 * 1024, (const bf16*)(ws + OFF_VC) + (size_t)j * 512 * 1024, OB,
                                 nullptr, nullptr, ARGS.diff_subln + j * 128, lam, 1.f - lam_init, 0.125f * 1.4426950408889634f, ctl + l, 8};

#ifndef SKIP_ATTN
 attn_phase<2, 64, 128, false, 1>(lds, a);
#ifdef PROBE_ATT
 GSYNC(); a.ctr = ctl + 4 + l; attn_phase<2, 64, 128, false, 1>(lds, a);
#endif
#endif
 }
                    GSYNC();
                    { pg8::Gemm gm{OB, (const bf16*)(ws + OFF_DWO + j * SZ_WO), NTOK, DM, DM}; pg8::StaticOrder S; S.init(NTOK, DM, G, bx);
                      EpiResid E{out, xso, out, modl + 5 * 1024, 1.f, ARGS.norm_g + (size_t)(l * 3 + 2) * DM, modl + 7 * 1024, SSLOT(l * 3 + 2), H};

#if !defined(ONLY) || ONLY == 2
      pg8::gemm_phase<EpiResid, pg8::StaticOrder, true, true>(lds, gm, S, E);
#endif
 }
                    if (defer_ok()) { if (bx >= IDLE_160) deferred_slot(lds, qpos, QUOTA_OUT_PROJ, IDLE_160); qpos += QUOTA_OUT_PROJ; }
                    GSYNC();
                } else {
                    { pg8::Gemm gm{H, (const bf16*)(ws + OFF_MDOWN + j * SZ_MDOWN), NTOK, 1280, DM}; pg8::StaticOrder S; S.init(NTOK, 1280, G, bx);
                      EpiDownRaw E{(float*)(ws + OFF_DOWN), SSLOT(l * 3 + 1), SHWSLOT(l * 3 + 1)};

#if !defined(ONLY) || ONLY == 3
      pg8::gemm_phase<EpiDownRaw, pg8::StaticOrder, true, true>(lds, gm, S, E);
#endif
 }
                    GSYNC();
                    mla_norm_phase(j);
                    GSYNC();
                    { pg8::Gemm gm{(const bf16*)(ws + OFF_CQ), (const bf16*)(ws + OFF_MQUP + j * SZ_MQUP), NTOK, 1536, 768}; pg8::StaticOrder S; S.init(NTOK, 1536, G, bx);
                      EpiBf16Plain E{QB, 1536};

#if !defined(ONLY) || ONLY == 4
      pg8::gemm_phase<EpiBf16Plain, pg8::StaticOrder, true, true>(lds, gm, S, E);
#endif
 }
                    { pg8::Gemm gm{(const bf16*)(ws + OFF_CKV + j * SZ_CKV), (const bf16*)(ws + OFF_MKVUP + j * SZ_MKVUP), NKV, 2048, 256}; pg8::StaticOrder S; S.init(NKV, 2048, G, bx);
                      EpiKVup E{KBUF, VBUF, ARGS.mla_k_norm + j * 96, (const float*)(ws + OFF_KPE + j * SZ_KPE), (const float*)(ws + OFF_KPSS + j * SZ_KPSS), (const float*)(ws + OFF_TABM)};

#if !defined(ONLY) || ONLY == 5
      pg8::gemm_phase<EpiKVup, pg8::StaticOrder, true, true>(lds, gm, S, E);
#endif
 }
                    GSYNC();
                    { AttnArgs a{QB, 1536, KBUF, 1536, VBUF, 1024, KBUF + (size_t)NTOK * 1536, VBUF + (size_t)NTOK * 1024, OB,
                                 ARGS.mla_q_norm + j * 96, (const float*)(ws + OFF_TABM), nullptr, 0.f, 0.f, 0.10206207261596575f * 1.4426950408889634f, ctl + l, 16};

#ifndef SKIP_ATTN2
 attn_phase<1, 96, 64, true, 2>(lds, a);
#ifdef PROBE_ATT
 GSYNC(); a.ctr = ctl + 4 + l; attn_phase<1, 96, 64, true, 2>(lds, a);
#endif
#endif
 }
                    GSYNC();
                    { pg8::Gemm gm{OB, (const bf16*)(ws + OFF_MWO + j * SZ_WO), NTOK, DM, DM}; pg8::StaticOrder S; S.init(NTOK, DM, G, bx);
                      EpiResid E{out, xso, out, modl + 5 * 1024, 1.f, ARGS.norm_g + (size_t)(l * 3 + 2) * DM, modl + 7 * 1024, SSLOT(l * 3 + 2), H};

#if !defined(ONLY) || ONLY == 6
      pg8::gemm_phase<EpiResid, pg8::StaticOrder, true, true>(lds, gm, S, E);
#endif
 }
                    if (defer_ok()) { if (bx >= IDLE_160) deferred_slot(lds, qpos, QUOTA_OUT_PROJ, IDLE_160); qpos += QUOTA_OUT_PROJ; }
                    GSYNC();
                }
            }
            const bool first = (l == 0 && f == 0);
            { pg8::Gemm gm{H, (const bf16*)(ws + OFF_WIN + (size_t)(l * 2 + f) * SZ_WIN), NTOK, 2 * DFF, DM}; pg8::StaticOrder S; S.init(NTOK, 2 * DFF, G, bx);
              EpiSwiglu E{ACT, SSLOT(l * 3 + 2 * f), SHWSLOT(l * 3 + 2 * f)};

#if !defined(ONLY) || ONLY == 7
      pg8::gemm_phase<EpiSwiglu, pg8::StaticOrder, true, true>(lds, gm, S, E);
#endif
 }
            if (defer_ok()) { if (bx >= IDLE_FFN_IN) deferred_slot(lds, qpos, QUOTA_FFN_IN, IDLE_FFN_IN); qpos += QUOTA_FFN_IN; }
            GSYNC();
            { pg8::Gemm gm{ACT, (const bf16*)(ws + OFF_WOUT + (size_t)(l * 2 + f) * SZ_WOUT), NTOK, DM, DFF}; pg8::StaticOrder S; S.init(NTOK, DM, G, bx);
              const bool nonext = (l == 3 && f == 1);
              const float* gn = nonext ? (const float*)nullptr : (f == 0 ? ARGS.norm_g + (size_t)(l * 3 + 1) * DM : ARGS.norm_g + (size_t)((l + 1) * 3) * DM);
              const float* scn = f == 0 ? modl + 4 * 1024 : mod + (size_t)(l + 1) * 3 * NMOD + 1024;
              float* ssn = f == 0 ? SSLOT(l * 3 + 1) : SSLOT((l + 1) * 3);
              EpiResid E{first ? xp : out, first ? xs : xso, out, modl + (size_t)(2 + 6 * f) * 1024, 0.5f, gn, scn, ssn, H};

#if !defined(ONLY) || ONLY == 8
      pg8::gemm_phase<EpiResid, pg8::StaticOrder, true, true>(lds, gm, S, E);
#endif
 }
            if (defer_ok()) { if (bx >= IDLE_160) deferred_slot(lds, qpos, QUOTA_FFN_OUT, IDLE_160); qpos += QUOTA_FFN_OUT; }
            GSYNC();
        }
    }
}

#undef ws
#undef out
#undef mod
#undef H
#undef ACT
#undef QB
#undef KBUF
#undef VBUF
#undef OB
#undef ctl
#undef SSLOT
#undef SHWSLOT
#undef modl
#undef xp
#undef xs
#undef xso
extern "C" void kernel_launch(void* const* d_in, const int* in_sizes, int n_in, void* d_out, int out_size, void* d_ws, size_t ws_size, hipStream_t stream) {
    static int grid = 0;
    if (grid == 0) {
        if (n_in != 27 || (size_t)out_size != OUT_TOTAL || ws_size < WS_END) { fprintf(stderr, "kernel_launch: unexpected shapes (n_in %d, out %d, ws %zu, need %zu)\n", n_in, out_size, ws_size, (size_t)WS_END); grid = -1; return; }
        int dev = 0, cus = 0, per_cu = 0;
        hipGetDevice(&dev);
        hipDeviceGetAttribute(&cus, hipDeviceAttributeMultiprocessorCount, dev);
        hipFuncSetAttribute((const void*)mega_fwd, hipFuncAttributeMaxDynamicSharedMemorySize, LDS_BYTES);
        hipOccupancyMaxActiveBlocksPerMultiprocessor(&per_cu, (const void*)mega_fwd, NTHREADS, LDS_BYTES);
        if (per_cu < 1) { fprintf(stderr, "kernel_launch: occupancy query says %d blocks per CU\n", per_cu); grid = -1; return; }
        grid = cus * 1;
    }
    if (grid < 0) return;
    hipMemsetAsync((char*)d_ws + OFF_CTL, 0, 65536, stream);
    Args a{};
    const float** ap = (const float**)&a;
    for (int i = 0; i < 27; ++i) ap[i] = (const float*)d_in[i];
    a.out = (float*)d_out; a.ws = (unsigned char*)d_ws;
    void* args[] = {&a};
    hipError_t e = hipLaunchCooperativeKernel((const void*)mega_fwd, dim3(grid), dim3(NTHREADS), args, LDS_BYTES, stream);
    if (e != hipSuccess) fprintf(stderr, "cooperative launch failed: %s (grid %d)\n", hipGetErrorString(e), grid);
}
```

```cpp
#include <hip/hip_runtime.h>
#include <hip/hip_cooperative_groups.h>
#include <cstdio>
#include <cstdint>
namespace cg = cooperative_groups;
#define RESID_BATCH_M 2
namespace pg8 {
#define PG8_LAS __attribute__((address_space(3)))
typedef unsigned short bf16_t;
typedef short bf16x8 __attribute__((ext_vector_type(8)));
typedef float f32x4 __attribute__((ext_vector_type(4)));
typedef unsigned u32x4 __attribute__((ext_vector_type(4)));
constexpr int BM = 256, BK = 64, HALF = 128, HTB = HALF * BK * 2  , STAGE_BYTES = 8 * HTB, NXCD = 8, WGM = 8;

__host__ __device__ __forceinline__ int lds_byte(int r, int c) { const int st = (r >> 4) * 2 + (c >> 5), rr = r & 15, cc = c & 31, ob = rr * 64 + cc * 2; return st * 1024 + (ob ^ (((ob >> 9) & 1) << 5)); }
__host__ __device__ __forceinline__ void stage_rc(int b, int& R, int& C) { const int st = b / 1024, sb = b % 1024, swz = sb ^ (((sb >> 9) & 1) << 5); R = (st >> 1) * 16 + swz / 64; C = (st & 1) * 32 + (swz % 64) / 2; }
__host__ __device__ __forceinline__ int perm32(int rho) { const int n = rho >> 4, i = rho & 15; return 8 * (i >> 2) + 4 * n + (i & 3); }

struct Unit { int pm, pn; };
struct Gemm { const bf16_t* A; const bf16_t* Bt; int M, N, K; };

struct StaticOrder {
    int nM, nN, nwg, G, c;
    __host__ __device__ void init(int M, int N, int G_, int c_) { nM = M / BM; nN = N / BM; nwg = nM * nN; G = G_; c = c_; }
    __host__ __device__ bool next(int i, Unit& u) const {
        const long L = (long)i * G + c; if (L >= nwg) return false;
        int wgid = (int)L; { const int q = nwg / NXCD, r = nwg % NXCD, xcd = wgid % NXCD, off = wgid / NXCD; wgid = (xcd < r ? xcd * (q + 1) : r * (q + 1) + (xcd - r) * q) + off; }
        const int nig = WGM * nN, gid = wgid / nig, fm = gid * WGM, gsz = (nM - fm) < WGM ? (nM - fm) : WGM;
        u.pm = fm + ((wgid % nig) % gsz); u.pn = (wgid % nig) / gsz; return true;
    }
    __device__ __forceinline__ void a_ready(const Unit&) const {}
    __device__ __forceinline__ void done(const Unit&) const {}
};

__device__ __forceinline__ unsigned cvt_pk_bf16(float lo, float hi) { unsigned r; asm volatile("v_cvt_pk_bf16_f32 %0, %1, %2" : "=v"(r) : "v"(lo), "v"(hi)); return r; }
typedef float f32x2 __attribute__((ext_vector_type(2)));
template <class Epi, class Sched, bool ALIGN_EPI = false, bool SP2 = false>
__device__ __forceinline__ void gemm_phase(PG8_LAS unsigned char* lds, const Gemm g, const Sched& S, const Epi& E) {
    int tid_o = threadIdx.x; asm volatile("" : "+v"(tid_o));
    const int tid = tid_o, wid = __builtin_amdgcn_readfirstlane(tid >> 6), lane = tid & 63, wr = wid >> 2, wc = wid & 3, fr = lane & 15, fq = lane >> 4;
    int K_o = g.K; asm volatile("" : "+s"(K_o)); const int K = K_o, nt = K / BK;
    unsigned voffA[2], voffB[2];
#pragma unroll
    for (int i = 0; i < 2; ++i) { int R, C; stage_rc(tid * 16 + i * 8192, R, C); const int Rb = Epi::PERM ? ((R & ~31) + perm32(R & 31)) : R;
        voffA[i] = (unsigned)(R * K + C) * 2u; voffB[i] = (unsigned)(Rb * K + C) * 2u; }
    const size_t kstep = (size_t)(BK * 2);
    const size_t hstep = (size_t)HALF * K * 2;
    const size_t tstep = 2 * hstep;
    const unsigned ldsw = (unsigned)wid * 1024u;
    const int aoff = lds_byte(wr * 64 + fr, fq * 8), boff = lds_byte(wc * 32 + fr, fq * 8);
#define PG8_SA(b, h) (((b) * 2 + (h)) * HTB)
#define PG8_SB(b, h) ((4 + (b) * 2 + (h)) * HTB)
#define PG8_STAGE(bufoff, gbase, voff) do { _Pragma("unroll") for (int _i = 0; _i < 2; ++_i) \
        __builtin_amdgcn_global_load_lds((const unsigned*)((const char*)(gbase) + (voff)[_i]), (PG8_LAS unsigned*)(lds + (bufoff) + ldsw + _i * 8192), 16, 0, 0); } while (0)
#define PG8_LDA(dst, b, h) do { _Pragma("unroll") for (int m = 0; m < 4; ++m) _Pragma("unroll") for (int k = 0; k < 2; ++k) dst[m][k] = *(const PG8_LAS bf16x8*)(lds + PG8_SA(b, h) + aoff + m * 2048 + k * 1024); } while (0)
#define PG8_LDB(dst, b, h) do { _Pragma("unroll") for (int n = 0; n < 2; ++n) _Pragma("unroll") for (int k = 0; k < 2; ++k) dst[n][k] = *(const PG8_LAS bf16x8*)(lds + PG8_SB(b, h) + boff + n * 2048 + k * 1024); } while (0)
#define PG8_MMA(ai, bj, At, Bt) do { __builtin_amdgcn_s_setprio(1); _Pragma("unroll") for (int m = 0; m < 4; ++m) _Pragma("unroll") for (int n = 0; n < 2; ++n) _Pragma("unroll") for (int k = 0; k < 2; ++k) \
        acc[ai][bj][m][n] = __builtin_amdgcn_mfma_f32_16x16x32_bf16(Bt[n][k], At[m][k], acc[ai][bj][m][n], 0, 0, 0); __builtin_amdgcn_s_setprio(0); } while (0)
#define PG8_WAIT_V(n) asm volatile("s_waitcnt vmcnt(" #n ")" ::: "memory")
#define PG8_WAIT_L(n) asm volatile("s_waitcnt lgkmcnt(" #n ")" ::: "memory")
#define PG8_BAR __builtin_amdgcn_s_barrier()
#define PG8_SCHED __builtin_amdgcn_sched_barrier(0)
    Unit cur, nxt; int ui = 0;
    if (!S.next(0, cur)) return;
    f32x4 acc[2][2][4][2];
#pragma unroll
    for (int a = 0; a < 2; ++a)
#pragma unroll
        for (int b = 0; b < 2; ++b)
#pragma unroll
            for (int m = 0; m < 4; ++m)
#pragma unroll
                for (int n = 0; n < 2; ++n) acc[a][b][m][n] = (f32x4){0.f, 0.f, 0.f, 0.f};
    bf16x8 At[4][2], B0[2][2], B1[2][2];
    const char* cA = (const char*)g.A + (size_t)cur.pm * tstep; const char* cB = (const char*)g.Bt + (size_t)cur.pn * tstep;
    S.a_ready(cur);
    if constexpr (SP2) {
        PG8_STAGE(PG8_SB(0, 0), cB, voffB); PG8_STAGE(PG8_SB(0, 1), cB + hstep, voffB); PG8_STAGE(PG8_SA(0, 0), cA, voffA); PG8_STAGE(PG8_SA(0, 1), cA + hstep, voffA);
        if (wr == 1) PG8_BAR;
        PG8_WAIT_V(2); PG8_BAR;
        PG8_STAGE(PG8_SB(1, 0), cB + kstep, voffB); PG8_STAGE(PG8_SA(1, 0), cA + kstep, voffA); PG8_STAGE(PG8_SB(1, 1), cB + hstep + kstep, voffB);
        PG8_WAIT_V(6); PG8_BAR;
    } else {
        PG8_STAGE(PG8_SB(0, 0), cB, voffB); PG8_STAGE(PG8_SA(0, 0), cA, voffA); PG8_STAGE(PG8_SB(0, 1), cB + hstep, voffB); PG8_STAGE(PG8_SA(0, 1), cA + hstep, voffA);
        if (wr == 1) PG8_BAR;
        PG8_WAIT_V(4); PG8_BAR;
        PG8_STAGE(PG8_SB(1, 0), cB + kstep, voffB); PG8_STAGE(PG8_SA(1, 0), cA + kstep, voffA); PG8_STAGE(PG8_SB(1, 1), cB + hstep + kstep, voffB);
        PG8_WAIT_V(6); PG8_BAR;
    }
    for (;;) {
        const bool has_next = S.next(ui + 1, nxt);
        const char* nA = has_next ? (const char*)g.A + (size_t)nxt.pm * tstep : cA; const char* nB = has_next ? (const char*)g.Bt + (size_t)nxt.pn * tstep : cB;
        for (int t = 0; t < nt; t += 2) {
            const bool last = (t == nt - 2);
            const char* a1 = cA + (size_t)(t + 1) * kstep;
            const char* a2 = last ? nA : cA + (size_t)(t + 2) * kstep; const char* b2 = last ? nB : cB + (size_t)(t + 2) * kstep;
            const char* a3 = a2 + kstep; const char* b3 = b2 + kstep;
            if (last && has_next) S.a_ready(nxt);
            if constexpr (SP2) {
            PG8_LDB(B0, 0, 0); PG8_LDB(B1, 0, 1); PG8_SCHED; PG8_LDA(At, 0, 0); PG8_STAGE(PG8_SA(1, 1), a1 + hstep, voffA);
            PG8_WAIT_V(8); PG8_WAIT_L(0); PG8_BAR; PG8_MMA(0, 0, At, B0); PG8_MMA(0, 1, At, B1); PG8_BAR; PG8_SCHED;
            PG8_LDA(At, 0, 1); PG8_STAGE(PG8_SB(0, 0), b2, voffB); PG8_STAGE(PG8_SB(0, 1), b2 + hstep, voffB); PG8_STAGE(PG8_SA(0, 0), a2, voffA);
            PG8_WAIT_V(8); PG8_WAIT_L(0); PG8_BAR; PG8_MMA(1, 0, At, B0); PG8_MMA(1, 1, At, B1); PG8_BAR; PG8_SCHED;
            PG8_LDB(B0, 1, 0); PG8_LDB(B1, 1, 1); PG8_SCHED; PG8_LDA(At, 1, 0); PG8_STAGE(PG8_SA(0, 1), a2 + hstep, voffA);
            PG8_WAIT_V(8); PG8_WAIT_L(0); PG8_BAR; PG8_MMA(0, 0, At, B0); PG8_MMA(0, 1, At, B1); PG8_BAR; PG8_SCHED;
            PG8_LDA(At, 1, 1); PG8_STAGE(PG8_SB(1, 0), b3, voffB); PG8_STAGE(PG8_SB(1, 1), b3 + hstep, voffB); PG8_STAGE(PG8_SA(1, 0), a3, voffA);
            PG8_WAIT_V(8); PG8_WAIT_L(0); PG8_BAR; PG8_MMA(1, 0, At, B0); PG8_MMA(1, 1, At, B1); PG8_BAR; PG8_SCHED;
            } else {
            PG8_LDB(B0, 0, 0); PG8_SCHED; PG8_LDA(At, 0, 0); PG8_STAGE(PG8_SA(1, 1), a1 + hstep, voffA);
            PG8_WAIT_L(8); PG8_BAR; PG8_WAIT_L(0); PG8_MMA(0, 0, At, B0); PG8_BAR; PG8_SCHED;
            PG8_LDB(B1, 0, 1); PG8_STAGE(PG8_SB(0, 0), b2, voffB);
            PG8_BAR; PG8_WAIT_L(0); PG8_MMA(0, 1, At, B1); PG8_BAR;
            PG8_LDA(At, 0, 1); PG8_STAGE(PG8_SA(0, 0), a2, voffA);
            PG8_BAR; PG8_WAIT_L(0); PG8_MMA(1, 0, At, B0); PG8_BAR; PG8_SCHED;
            PG8_STAGE(PG8_SB(0, 1), b2 + hstep, voffB);
            PG8_WAIT_V(6); PG8_BAR; PG8_MMA(1, 1, At, B1); PG8_BAR;
            PG8_LDB(B0, 1, 0); PG8_SCHED; PG8_LDA(At, 1, 0); PG8_STAGE(PG8_SA(0, 1), a2 + hstep, voffA);
            PG8_WAIT_L(8); PG8_BAR; PG8_WAIT_L(0); PG8_MMA(0, 0, At, B0); PG8_BAR; PG8_SCHED;
            PG8_LDB(B1, 1, 1); PG8_STAGE(PG8_SB(1, 0), b3, voffB);
            PG8_BAR; PG8_WAIT_L(0); PG8_MMA(0, 1, At, B1); PG8_BAR;
            PG8_LDA(At, 1, 1); PG8_STAGE(PG8_SA(1, 0), a3, voffA);
            PG8_BAR; PG8_WAIT_L(0); PG8_MMA(1, 0, At, B0); PG8_BAR; PG8_SCHED;
            PG8_STAGE(PG8_SB(1, 1), b3 + hstep, voffB);
            PG8_WAIT_V(6); PG8_BAR; PG8_MMA(1, 1, At, B1); PG8_BAR;
            }
        }
        if constexpr (ALIGN_EPI) { if (wr == 0) PG8_BAR; }
        if constexpr (!Epi::AFTER_DRAIN) { E(acc, cur, wr, wc, fr, fq); S.done(cur); }
        if (!has_next) break;
#pragma unroll
        for (int a = 0; a < 2; ++a)
#pragma unroll
            for (int b = 0; b < 2; ++b)
#pragma unroll
                for (int m = 0; m < 4; ++m)
#pragma unroll
                    for (int n = 0; n < 2; ++n) acc[a][b][m][n] = (f32x4){0.f, 0.f, 0.f, 0.f};
        cur = nxt; cA = nA; cB = nB; ++ui;
        if constexpr (ALIGN_EPI) { if (wr == 1) PG8_BAR; }
    }
    PG8_WAIT_V(0);
    if constexpr (!ALIGN_EPI) { if (wr == 0) PG8_BAR; }
    PG8_BAR;
    if constexpr (Epi::AFTER_DRAIN) { E.fused(acc, cur, wr, wc, fr, fq, lds, wid, lane); S.done(cur); }
#undef PG8_SA
#undef PG8_SB
#undef PG8_STAGE
#undef PG8_LDA
#undef PG8_LDB
#undef PG8_MMA
#undef PG8_WAIT_V
#undef PG8_WAIT_L
#undef PG8_BAR
#undef PG8_SCHED
}
}

#define GAS __attribute__((address_space(1)))
#define LAS __attribute__((address_space(3)))
typedef unsigned short bf16;
typedef unsigned u32x4 __attribute__((ext_vector_type(4)));
typedef unsigned u32x2 __attribute__((ext_vector_type(2)));
typedef float f32x4 __attribute__((ext_vector_type(4)));
typedef float f32x2 __attribute__((ext_vector_type(2)));
typedef short bf16x8 __attribute__((ext_vector_type(8)));
typedef short s16x4 __attribute__((ext_vector_type(4)));

constexpr int DM = 1024, NCTX = 8192, NLAT = 2048, NTOK = 10240, NKV = 10752, DFF = 2816, NMOD = 9216;
constexpr int NWAVES = 8, NTHREADS = 512;
constexpr float EPS = 1e-6f;
constexpr int LDS_BYTES = 147456;

constexpr size_t OUT_X = 0;
constexpr size_t OUT_DK = (size_t)NTOK * DM;
constexpr size_t OUT_DV = OUT_DK + (size_t)32 * 2 * 256 * 1024;
constexpr size_t OUT_CKV = OUT_DV + (size_t)32 * 2 * 256 * 1024;
constexpr size_t OUT_KPE = OUT_CKV + (size_t)32 * 2 * 256 * 256;
constexpr size_t OUT_TOTAL = OUT_KPE + (size_t)32 * 2 * 256 * 32;

constexpr size_t al4k(size_t x) { return (x + 4095) & ~(size_t)4095; }
constexpr size_t OFF_CTL = 0;
constexpr size_t OFF_MOD = 1u << 20;
constexpr size_t OFF_TABD = OFF_MOD + al4k((size_t)4 * 3 * NMOD * 4);
constexpr size_t OFF_TABM = OFF_TABD + al4k(64 * 16 * 2 * 4);
constexpr size_t SZ_WIN = (size_t)2 * DFF * DM * 2, SZ_WOUT = (size_t)DM * DFF * 2;
constexpr size_t OFF_WIN = OFF_TABM + al4k(64 * 8 * 2 * 4);
constexpr size_t OFF_WOUT = OFF_WIN + 8 * SZ_WIN;
constexpr size_t SZ_DQKV = (size_t)3072 * 1024 * 2, SZ_WO = (size_t)1024 * 1024 * 2, SZ_MDOWN = (size_t)1280 * 1024 * 2, SZ_MQUP = (size_t)1536 * 768 * 2, SZ_MKVUP = (size_t)2048 * 256 * 2;
constexpr size_t OFF_DQKV = OFF_WOUT + 8 * SZ_WOUT;
constexpr size_t OFF_DWO = OFF_DQKV + 2 * SZ_DQKV;
constexpr size_t OFF_MDOWN = OFF_DWO + 2 * SZ_WO;
constexpr size_t OFF_MQUP = OFF_MDOWN + 2 * SZ_MDOWN;
constexpr size_t OFF_MKVUP = OFF_MQUP + 2 * SZ_MQUP;
constexpr size_t OFF_MWO = OFF_MKVUP + 2 * SZ_MKVUP;
constexpr size_t OFF_H = OFF_MWO + 2 * SZ_WO;
constexpr size_t OFF_ACT = OFF_H + (size_t)NTOK * DM * 2;
constexpr size_t OFF_Q = OFF_ACT + (size_t)NTOK * DFF * 2;
constexpr size_t OFF_K = OFF_Q + (size_t)NTOK * 1536 * 2;
constexpr size_t OFF_V = OFF_K + (size_t)NKV * 1536 * 2;
constexpr size_t OFF_O = OFF_V + (size_t)NKV * 1024 * 2;
constexpr size_t OFF_KC = OFF_O + (size_t)NTOK * DM * 2;
constexpr size_t OFF_VC = OFF_KC + (size_t)2 * 512 * 1024 * 2;
constexpr size_t OFF_DOWN = OFF_VC + (size_t)2 * 512 * 1024 * 2;
constexpr size_t OFF_CQ = OFF_DOWN + (size_t)NTOK * 1056 * 4;
constexpr size_t SZ_CKV = (size_t)NKV * 256 * 2, SZ_KPE = (size_t)NKV * 32 * 4, SZ_KPSS = al4k((size_t)NKV * 4);
constexpr size_t OFF_CKV = OFF_CQ + (size_t)NTOK * 768 * 2;
constexpr size_t OFF_KPE = OFF_CKV + 2 * SZ_CKV;
constexpr size_t OFF_KPSS = OFF_KPE + 2 * SZ_KPE;
constexpr size_t OFF_SS = OFF_KPSS + 2 * SZ_KPSS;
constexpr size_t OFF_SHW = OFF_SS + (size_t)12 * NTOK * 4;
constexpr size_t WS_END = OFF_SHW + (size_t)12 * 3 * 5632 * 4;

struct Args {
    const float* x_prompt; const float* x_sample; const float* c; const float* cache_diff_k; const float* cache_diff_v; const float* cache_mla_ckv; const float* cache_mla_kpe; const float* c_ctx;
    const float* w_mod; const float* b_mod; const float* norm_g; const float* ffn_w_in; const float* ffn_w_out;
    const float* diff_w_qkv; const float* diff_q_norm; const float* diff_k_norm; const float* diff_lambda; const float* diff_subln; const float* diff_w_o;
    const float* mla_w_down; const float* mla_q_a_norm; const float* mla_kv_a_norm; const float* mla_w_q_up; const float* mla_w_kv_up; const float* mla_q_norm; const float* mla_k_norm; const float* mla_w_o;
    float* out; unsigned char* ws;
};

typedef const Args __attribute__((address_space(4))) CArgs;
__device__ __forceinline__ CArgs* KA() { CArgs* p = (CArgs*)__builtin_amdgcn_kernarg_segment_ptr(); asm volatile("" : "+s"(p)); return p; }
#define ARGS (*KA())
__device__ __forceinline__ int opaque_tid() { int t = threadIdx.x; asm volatile("" : "+v"(t)); return t; }
__device__ __forceinline__ unsigned f2bf(float f) { unsigned u = __builtin_bit_cast(unsigned, f); return (u + 0x7fffu + ((u >> 16) & 1u)) >> 16; }
__device__ __forceinline__ unsigned pk2(float lo, float hi) { return pg8::cvt_pk_bf16(lo, hi); }
__device__ __forceinline__ float bf2f(unsigned short b) { return __builtin_bit_cast(float, (unsigned)b << 16); }
__device__ __forceinline__ float wave_sum(float v) {
#pragma unroll
    for (int o = 1; o < 64; o <<= 1) v += __shfl_xor(v, o);
    return v;
}
__device__ __forceinline__ float quad_sum(float v) { v += __shfl_xor(v, 16); v += __shfl_xor(v, 32); return v; }
__device__ __forceinline__ float quad_max(float v) { v = fmaxf(v, __shfl_xor(v, 16)); v = fmaxf(v, __shfl_xor(v, 32)); return v; }
__device__ __forceinline__ float fast_silu(float g) { return g * __builtin_amdgcn_rcpf(1.f + __builtin_amdgcn_exp2f(-1.4426950408889634f * g)); }
__device__ __forceinline__ u32x4 pack8(const float* v) { u32x4 w; w.x = pk2(v[0], v[1]); w.y = pk2(v[2], v[3]); w.z = pk2(v[4], v[5]); w.w = pk2(v[6], v[7]); return w; }
__device__ __forceinline__ int tok_group(int row) { return row < NCTX ? 0 : 1 + ((row - NCTX) >> 10); }

#define EPI_VALS(v, ai, bj, m) float v[8]; { _Pragma("unroll") for (int _n = 0; _n < 2; ++_n) _Pragma("unroll") for (int _j = 0; _j < 4; ++_j) v[_n * 4 + _j] = acc[ai][bj][m][_n][_j]; }

#define EPI_NORMIN_DECL const float* ss; const float* shw;
#define EPI_NORMIN_SW(sw, u, wc, fq) float sw[2][8]; { const float* sp_ = shw + (size_t)tok_group((u).pm * 256) * 5632 + (u).pn * 256 + (wc) * 32 + 8 * (fq); \
    _Pragma("unroll") for (int bj_ = 0; bj_ < 2; ++bj_) { const f32x4 a_ = *(const f32x4*)(sp_ + bj_ * 128), b_ = *(const f32x4*)(sp_ + bj_ * 128 + 4); \
        sw[bj_][0] = a_.x; sw[bj_][1] = a_.y; sw[bj_][2] = a_.z; sw[bj_][3] = a_.w; sw[bj_][4] = b_.x; sw[bj_][5] = b_.y; sw[bj_][6] = b_.z; sw[bj_][7] = b_.w; } }
#define EPI_NORMIN_RSTD(rs, row0) float rs[2][4]; { _Pragma("unroll") for (int ai_ = 0; ai_ < 2; ++ai_) _Pragma("unroll") for (int m_ = 0; m_ < 4; ++m_) rs[ai_][m_] = ss[(row0) + ai_ * 128 + m_ * 16]; \
    _Pragma("unroll") for (int ai_ = 0; ai_ < 2; ++ai_) _Pragma("unroll") for (int m_ = 0; m_ < 4; ++m_) rs[ai_][m_] = __builtin_amdgcn_rsqf(rs[ai_][m_] * (1.f / DM) + EPS); }
#define EPI_NORMIN_APPLY(v, bj, rstd, sw) { _Pragma("unroll") for (int i_ = 0; i_ < 8; ++i_) v[i_] = v[i_] * (rstd) + sw[bj][i_]; }

struct EpiSwiglu {
    static constexpr bool PERM = true, AFTER_DRAIN = false;
    bf16* ACT; EPI_NORMIN_DECL
    __device__ __forceinline__ void operator()(const pg8::f32x4 (&acc)[2][2][4][2], const pg8::Unit& u, int wr, int wc, int fr, int fq) const {
        const int row0 = u.pm * 256 + wr * 64 + fr, col = u.pn * 128 + wc * 32 + 8 * fq;
        EPI_NORMIN_SW(sw, u, wc, fq);
        EPI_NORMIN_RSTD(rsv, row0);
#pragma unroll
        for (int ai = 0; ai < 2; ++ai)
#pragma unroll
            for (int m = 0; m < 4; ++m) {
                EPI_VALS(g, ai, 0, m); EPI_VALS(uu, ai, 1, m);
                const float rstd = rsv[ai][m];
                EPI_NORMIN_APPLY(g, 0, rstd, sw); EPI_NORMIN_APPLY(uu, 1, rstd, sw);
                float r[8];
#pragma unroll
                for (int i = 0; i < 8; ++i) r[i] = fast_silu(g[i]) * uu[i];
                *(u32x4*)(ACT + (size_t)(row0 + ai * 128 + m * 16) * DFF + col) = pack8(r);
            }
    }
};

struct EpiResid {
    static constexpr bool PERM = true, AFTER_DRAIN = false;
    const float* xp; const float* xs; float* out; const float* gate; float scale;
    const float* gnext; const float* scnext; float* ssnext; bf16* XG;
    __device__ __forceinline__ void operator()(const pg8::f32x4 (&acc)[2][2][4][2], const pg8::Unit& u, int wr, int wc, int fr, int fq) const {
        const int row0 = u.pm * 256 + wr * 64 + fr, cb = u.pn * 256 + wc * 32 + 8 * fq;
        const int grp = tok_group(u.pm * 256);
        float gv[2][8];
#pragma unroll
        for (int bj = 0; bj < 2; ++bj) { const f32x4 a = *(const f32x4*)(gate + (size_t)grp * NMOD + cb + bj * 128), b = *(const f32x4*)(gate + (size_t)grp * NMOD + cb + bj * 128 + 4);
            gv[bj][0] = a.x * scale; gv[bj][1] = a.y * scale; gv[bj][2] = a.z * scale; gv[bj][3] = a.w * scale; gv[bj][4] = b.x * scale; gv[bj][5] = b.y * scale; gv[bj][6] = b.z * scale; gv[bj][7] = b.w * scale; }
        const bool hasnext = gnext != nullptr;
        float gsv[2][8];
        if (hasnext) {
#pragma unroll
            for (int bj = 0; bj < 2; ++bj) { const f32x4 a = *(const f32x4*)(gnext + cb + bj * 128), b = *(const f32x4*)(gnext + cb + bj * 128 + 4);
                const f32x4 c = *(const f32x4*)(scnext + (size_t)grp * NMOD + cb + bj * 128), d = *(const f32x4*)(scnext + (size_t)grp * NMOD + cb + bj * 128 + 4);
                gsv[bj][0] = a.x * (1.f + c.x); gsv[bj][1] = a.y * (1.f + c.y); gsv[bj][2] = a.z * (1.f + c.z); gsv[bj][3] = a.w * (1.f + c.w);
                gsv[bj][4] = b.x * (1.f + d.x); gsv[bj][5] = b.y * (1.f + d.y); gsv[bj][6] = b.z * (1.f + d.z); gsv[bj][7] = b.w * (1.f + d.w); }
        }
#ifndef RESID_BATCH_M
#define RESID_BATCH_M 4
#endif
#pragma unroll
        for (int ai = 0; ai < 2; ++ai)
#pragma unroll
            for (int mb = 0; mb < 4; mb += RESID_BATCH_M) {
                f32x4 xl[RESID_BATCH_M][2][2];
#pragma unroll
                for (int mm = 0; mm < RESID_BATCH_M; ++mm) { const int row = row0 + ai * 128 + (mb + mm) * 16;
                    const float* xo = row < NCTX ? xp + (size_t)row * DM : xs + (size_t)(row - NCTX) * DM;
#pragma unroll
                    for (int bj = 0; bj < 2; ++bj) { xl[mm][bj][0] = *(const f32x4*)(xo + cb + bj * 128); xl[mm][bj][1] = *(const f32x4*)(xo + cb + bj * 128 + 4); } }
#pragma unroll
                for (int mm = 0; mm < RESID_BATCH_M; ++mm) {
                    const int m = mb + mm;
                    const int row = row0 + ai * 128 + m * 16;
                    float* o = out + (size_t)row * DM;
                    float ssl = 0.f;
#pragma unroll
                    for (int bj = 0; bj < 2; ++bj) {
                        EPI_VALS(v, ai, bj, m);
                        const f32x4 x0 = xl[mm][bj][0], x1 = xl[mm][bj][1];
                        float xn[8];
                        xn[0] = x0.x + gv[bj][0] * v[0]; xn[1] = x0.y + gv[bj][1] * v[1]; xn[2] = x0.z + gv[bj][2] * v[2]; xn[3] = x0.w + gv[bj][3] * v[3];
                        xn[4] = x1.x + gv[bj][4] * v[4]; xn[5] = x1.y + gv[bj][5] * v[5]; xn[6] = x1.z + gv[bj][6] * v[6]; xn[7] = x1.w + gv[bj][7] * v[7];
                        *(f32x4*)(o + cb + bj * 128) = (f32x4){xn[0], xn[1], xn[2], xn[3]}; *(f32x4*)(o + cb + bj * 128 + 4) = (f32x4){xn[4], xn[5], xn[6], xn[7]};
                        if (hasnext) {
#pragma unroll
                            for (int i = 0; i < 8; ++i) { ssl += xn[i] * xn[i]; xn[i] *= gsv[bj][i]; }
                            *(u32x4*)(XG + (size_t)row * DM + cb + bj * 128) = pack8(xn);
                        }
                    }
                    if (hasnext) { ssl = quad_sum(ssl); if (fq == 0) __hip_atomic_fetch_add(ssnext + row, ssl, __ATOMIC_RELAXED, __HIP_MEMORY_SCOPE_AGENT); }
                }
            }
    }
};

struct EpiDiffQKV {
    static constexpr bool PERM = true, AFTER_DRAIN = false;
    bf16* Q; bf16* K; bf16* V; const float* qg; const float* kg; const float* tabD; float* out_k; float* out_v; int j; EPI_NORMIN_DECL
    __device__ __forceinline__ void operator()(const pg8::f32x4 (&acc)[2][2][4][2], const pg8::Unit& u, int wr, int wc, int fr, int fq) const {
        const int row0 = u.pm * 256 + wr * 64 + fr;
        const int G = 4 * u.pn + wc, type = G >> 4, hc = G & 15;
        const bool lat = u.pm >= 32;
        EPI_NORMIN_SW(sw, u, wc, fq);
        EPI_NORMIN_RSTD(rsv, row0);
        float gain[2][8];
        if (type < 2) { const float* gp = type == 0 ? qg : kg;
#pragma unroll
            for (int bj = 0; bj < 2; ++bj)
#pragma unroll
                for (int i = 0; i < 8; ++i) gain[bj][i] = gp[32 * bj + 8 * fq + i]; }
#pragma unroll
        for (int ai = 0; ai < 2; ++ai)
#pragma unroll
            for (int m = 0; m < 4; ++m) {
                __builtin_amdgcn_sched_barrier(0);
                const int row = row0 + ai * 128 + m * 16;
                EPI_VALS(v0, ai, 0, m); EPI_VALS(v1, ai, 1, m);
                { const float rstd_in = rsv[ai][m]; EPI_NORMIN_APPLY(v0, 0, rstd_in, sw); EPI_NORMIN_APPLY(v1, 1, rstd_in, sw); }
                const size_t dcol = (size_t)hc * 64 + 8 * fq;
                if (type < 2) {
                    float ss = 0.f;
#pragma unroll
                    for (int i = 0; i < 8; ++i) ss += v0[i] * v0[i] + v1[i] * v1[i];
                    ss = quad_sum(ss);
                    const float rstd = __builtin_amdgcn_rsqf(ss * (1.f / 64.f) + EPS);
#pragma unroll
                    for (int i = 0; i < 8; ++i) { v0[i] = v0[i] * rstd * gain[0][i]; v1[i] = v1[i] * rstd * gain[1][i]; }
                    if (lat) {
                        const int t = (row - NCTX) & 1023, prow = t >> 6, pcol = t & 63;
                        const float* t0 = tabD + (size_t)(prow * 16 + 8 * (fq & 1)) * 2; const float* t1 = tabD + (size_t)(pcol * 16 + 8 * (fq & 1)) * 2;
#pragma unroll
                        for (int i = 0; i < 8; ++i) {
                            const float p0 = __shfl_xor(v0[i], 32), p1 = __shfl_xor(v1[i], 32);
                            const float c0 = t0[2 * i], s0 = t0[2 * i + 1], c1 = t1[2 * i], s1 = t1[2 * i + 1];
                            v0[i] = fq < 2 ? v0[i] * c0 - p0 * s0 : v0[i] * c0 + p0 * s0;
                            v1[i] = fq < 2 ? v1[i] * c1 - p1 * s1 : v1[i] * c1 + p1 * s1;
                        }
                    }
                    bf16* dst = (type == 0 ? Q : K) + (size_t)row * 1024 + dcol;
                    *(u32x4*)(dst) = pack8(v0); *(u32x4*)(dst + 32) = pack8(v1);
                    if (type == 1 && !lat) {
                        const int b = row >> 8, s = row & 255;
                        float* o = out_k + ((size_t)(b * 2 + j) * 256 + s) * 1024 + dcol;
                        *(f32x4*)(o) = (f32x4){v0[0], v0[1], v0[2], v0[3]}; *(f32x4*)(o + 4) = (f32x4){v0[4], v0[5], v0[6], v0[7]};
                        *(f32x4*)(o + 32) = (f32x4){v1[0], v1[1], v1[2], v1[3]}; *(f32x4*)(o + 36) = (f32x4){v1[4], v1[5], v1[6], v1[7]};
                    }
                } else {
                    bf16* dst = V + (size_t)row * 1024 + dcol;
                    *(u32x4*)(dst) = pack8(v0); *(u32x4*)(dst + 32) = pack8(v1);
                    if (!lat) {
                        const int b = row >> 8, s = row & 255;
                        float* o = out_v + ((size_t)(b * 2 + j) * 256 + s) * 1024 + dcol;
                        *(f32x4*)(o) = (f32x4){v0[0], v0[1], v0[2], v0[3]}; *(f32x4*)(o + 4) = (f32x4){v0[4], v0[5], v0[6], v0[7]};
                        *(f32x4*)(o + 32) = (f32x4){v1[0], v1[1], v1[2], v1[3]}; *(f32x4*)(o + 36) = (f32x4){v1[4], v1[5], v1[6], v1[7]};
                    }
                }
            }
    }
};

struct EpiDownRaw {
    static constexpr bool PERM = true, AFTER_DRAIN = false;
    float* DOWN; EPI_NORMIN_DECL
    __device__ __forceinline__ void operator()(const pg8::f32x4 (&acc)[2][2][4][2], const pg8::Unit& u, int wr, int wc, int fr, int fq) const {
        const int row0 = u.pm * 256 + wr * 64 + fr, cb = u.pn * 256 + wc * 32 + 8 * fq;
        EPI_NORMIN_SW(sw, u, wc, fq);
        EPI_NORMIN_RSTD(rsv, row0);
#pragma unroll
        for (int ai = 0; ai < 2; ++ai)
#pragma unroll
            for (int m = 0; m < 4; ++m) {
                const int row = row0 + ai * 128 + m * 16;
                float* o = DOWN + (size_t)row * 1056;
                const float rstd = rsv[ai][m];
#pragma unroll
                for (int bj = 0; bj < 2; ++bj) { const int c = cb + bj * 128;
                    if (c < 1056) { EPI_VALS(v, ai, bj, m); EPI_NORMIN_APPLY(v, bj, rstd, sw);
                        *(f32x4*)(o + c) = (f32x4){v[0], v[1], v[2], v[3]}; *(f32x4*)(o + c + 4) = (f32x4){v[4], v[5], v[6], v[7]}; } }
            }
    }
};

struct EpiBf16Plain {
    static constexpr bool PERM = true, AFTER_DRAIN = false;
    bf16* O; int ldc;
    __device__ __forceinline__ void operator()(const pg8::f32x4 (&acc)[2][2][4][2], const pg8::Unit& u, int wr, int wc, int fr, int fq) const {
        const int row0 = u.pm * 256 + wr * 64 + fr, cb = u.pn * 256 + wc * 32 + 8 * fq;
#pragma unroll
        for (int ai = 0; ai < 2; ++ai)
#pragma unroll
            for (int m = 0; m < 4; ++m) {
                bf16* o = O + (size_t)(row0 + ai * 128 + m * 16) * ldc + cb;
#pragma unroll
                for (int bj = 0; bj < 2; ++bj) { EPI_VALS(v, ai, bj, m); *(u32x4*)(o + bj * 128) = pack8(v); }
            }
    }
};

struct EpiKVup {
    static constexpr bool PERM = true, AFTER_DRAIN = false;
    bf16* KM; bf16* VM; const float* kg; const float* KPE; const float* KPSS; const float* tabM;
    __device__ __forceinline__ void operator()(const pg8::f32x4 (&acc)[2][2][4][2], const pg8::Unit& u, int wr, int wc, int fr, int fq) const {
        const int row0 = u.pm * 256 + wr * 64 + fr;
        const int G = 4 * u.pn + wc, head = G >> 1, part = G & 1;
        const bool lat = u.pm >= 32 && u.pm < 40;
        float kps[2][4];
        if (part == 0) {
#pragma unroll
            for (int ai_ = 0; ai_ < 2; ++ai_)
#pragma unroll
                for (int m_ = 0; m_ < 4; ++m_) kps[ai_][m_] = KPSS[row0 + ai_ * 128 + m_ * 16];
        }
        float gain[2][8];
        if (part == 0) {
#pragma unroll
            for (int bj = 0; bj < 2; ++bj)
#pragma unroll
                for (int i = 0; i < 8; ++i) gain[bj][i] = kg[32 * bj + 8 * fq + i];
        }
#pragma unroll
        for (int ai = 0; ai < 2; ++ai)
#pragma unroll
            for (int m = 0; m < 4; ++m) {
                __builtin_amdgcn_sched_barrier(0);
                const int row = row0 + ai * 128 + m * 16;
                EPI_VALS(v0, ai, 0, m); EPI_VALS(v1, ai, 1, m);
                if (part == 0) {
                    float ss = 0.f;
#pragma unroll
                    for (int i = 0; i < 8; ++i) ss += v0[i] * v0[i] + v1[i] * v1[i];
                    ss = quad_sum(ss) + kps[ai][m];
                    const float rstd = __builtin_amdgcn_rsqf(ss * (1.f / 96.f) + EPS);
#pragma unroll
                    for (int i = 0; i < 8; ++i) { v0[i] = v0[i] * rstd * gain[0][i]; v1[i] = v1[i] * rstd * gain[1][i]; }
                    bf16* dst = KM + (size_t)row * 1536 + head * 96 + 8 * fq;
                    *(u32x4*)(dst) = pack8(v0); *(u32x4*)(dst + 32) = pack8(v1);
                    const float* kp = KPE + (size_t)row * 32;
                    const f32x4 a0 = *(const f32x4*)(kp + 8 * fq), a1 = *(const f32x4*)(kp + 8 * fq + 4);
                    float mine[8] = {a0.x * rstd, a0.y * rstd, a0.z * rstd, a0.w * rstd, a1.x * rstd, a1.y * rstd, a1.z * rstd, a1.w * rstd};
                    if (lat) {
                        const int t = (row - NCTX) & 1023, pos = (fq >> 1) ? (t & 63) : (t >> 6);
                        const float* tb = tabM + (size_t)pos * 16;
#pragma unroll
                        for (int i = 0; i < 8; ++i) { const float pp = __shfl_xor(mine[i], 16), c = tb[2 * i], s = tb[2 * i + 1];
                            mine[i] = (fq & 1) == 0 ? mine[i] * c - pp * s : mine[i] * c + pp * s; }
                    }
                    *(u32x4*)(KM + (size_t)row * 1536 + head * 96 + 64 + 8 * fq) = pack8(mine);
                } else {
                    bf16* dst = VM + (size_t)row * 1024 + head * 64 + 8 * fq;
                    *(u32x4*)(dst) = pack8(v0); *(u32x4*)(dst + 32) = pack8(v1);
                }
            }
    }
};

__device__ __forceinline__ int rowmap(int mode, int c) {
    if (mode == 1) { return c < DFF ? 256 * (c >> 7) + (c & 127) : 256 * ((c - DFF) >> 7) + 128 + ((c - DFF) & 127); }
    if (mode == 2) { const int G = c >> 6, e = c & 63; return 256 * (G >> 2) + 128 * (e >> 5) + 32 * (G & 3) + (e & 31); }
    return c;
}
__device__ __forceinline__ void xpose_item(const float* W, int K, int N, bf16* WT, int mode, LAS float* scr, int item, int lane, const float* sh = nullptr, float* shw = nullptr) {
    const int nblk = N / 32, kb = item / nblk, nb = item % nblk, k0 = 64 * kb, n0 = 32 * nb;
    {
        float wv[32];
        const float* wsrc = W + (size_t)(k0 + (lane >> 5)) * N + n0 + (lane & 31);
#pragma unroll
        for (int i = 0; i < 32; ++i) wv[i] = __builtin_nontemporal_load(wsrc + (size_t)(2 * i) * N);
#pragma unroll
        for (int i = 0; i < 32; ++i) scr[(2 * i + (lane >> 5)) * 33 + (lane & 31)] = wv[i];
    }
    asm volatile("s_waitcnt lgkmcnt(0)" ::: "memory");
    const int c = lane & 7, r0 = rowmap(mode, n0);
#pragma unroll
    for (int jj = 0; jj < 4; ++jj) { const int n = (lane >> 3) + 8 * jj; const LAS float* s = scr + (8 * c) * 33 + n;
        u32x4 o; o.x = pk2(s[0 * 33], s[1 * 33]); o.y = pk2(s[2 * 33], s[3 * 33]); o.z = pk2(s[4 * 33], s[5 * 33]); o.w = pk2(s[6 * 33], s[7 * 33]);
        __builtin_nontemporal_store(o, (u32x4*)(WT + (size_t)(r0 + n) * K + k0 + 8 * c)); }
    if (sh) {
        LAS float* s2 = scr + 64 * 33;
#pragma unroll
        for (int g = 0; g < 3; ++g) s2[g * 64 + lane] = sh[(size_t)g * NMOD + k0 + lane];
        asm volatile("s_waitcnt lgkmcnt(0)" ::: "memory");
        const int n = lane & 31, hf = lane >> 5;
        float a0 = 0.f, a1 = 0.f, a2 = 0.f;
#pragma unroll 8
        for (int kk = 0; kk < 32; ++kk) { const int k = hf * 32 + kk; const float w = scr[k * 33 + n]; a0 += w * s2[k]; a1 += w * s2[64 + k]; a2 += w * s2[128 + k]; }
        a0 += __shfl_xor(a0, 32); a1 += __shfl_xor(a1, 32); a2 += __shfl_xor(a2, 32);
        if (lane < 32) {
            __hip_atomic_fetch_add(shw + r0 + n, a0, __ATOMIC_RELAXED, __HIP_MEMORY_SCOPE_AGENT);
            __hip_atomic_fetch_add(shw + 5632 + r0 + n, a1, __ATOMIC_RELAXED, __HIP_MEMORY_SCOPE_AGENT);
            __hip_atomic_fetch_add(shw + 2 * 5632 + r0 + n, a2, __ATOMIC_RELAXED, __HIP_MEMORY_SCOPE_AGENT);
        }
    }
    asm volatile("s_waitcnt lgkmcnt(0)" ::: "memory");
}

constexpr int I_WIN = 16 * 176, I_WOUT = 44 * 32, I_DQKV = 16 * 96, I_WO = 16 * 32, I_MDOWN = 16 * 33, I_MQUP = 12 * 48, I_MKVUP = 4 * 64;
__device__ __forceinline__ int layer_items(int L) { return 2 * I_WIN + 2 * I_WOUT + ((L & 1) ? I_MDOWN + I_MQUP + I_MKVUP + I_WO : I_DQKV + I_WO); }
__device__ __forceinline__ void xpose_layer_item(int L, int r, LAS float* scr, int lane) {
    unsigned char* ws = ARGS.ws;
    const float* mod = (const float*)(ws + OFF_MOD); float* SHW = (float*)(ws + OFF_SHW);
    const int j = L >> 1;
    const float* shm = mod + (size_t)L * 3 * NMOD;
    if (r < 2 * I_WIN) { const int f = r / I_WIN, w = 2 * L + f, wh = 2 * f;
        xpose_item(ARGS.ffn_w_in + (size_t)w * DM * 2 * DFF, DM, 2 * DFF, (bf16*)(ws + OFF_WIN + w * SZ_WIN), 1, scr, r - f * I_WIN, lane, shm + (size_t)(3 * wh) * 1024, SHW + (size_t)(L * 3 + wh) * 3 * 5632); return; }
    r -= 2 * I_WIN;
    if (r < 2 * I_WOUT) { const int f = r / I_WOUT, w = 2 * L + f; xpose_item(ARGS.ffn_w_out + (size_t)w * DFF * DM, DFF, DM, (bf16*)(ws + OFF_WOUT + w * SZ_WOUT), 0, scr, r - f * I_WOUT, lane); return; }
    r -= 2 * I_WOUT;
    if ((L & 1) == 0) {
        if (r < I_DQKV) { xpose_item(ARGS.diff_w_qkv + (size_t)j * DM * 3072, DM, 3072, (bf16*)(ws + OFF_DQKV + j * SZ_DQKV), 2, scr, r, lane, shm + 3 * 1024, SHW + (size_t)(L * 3 + 1) * 3 * 5632); return; }
        r -= I_DQKV;
        xpose_item(ARGS.diff_w_o + (size_t)j * DM * DM, DM, DM, (bf16*)(ws + OFF_DWO + j * SZ_WO), 0, scr, r, lane);
    } else {
        if (r < I_MDOWN) { xpose_item(ARGS.mla_w_down + (size_t)j * DM * 1056, DM, 1056, (bf16*)(ws + OFF_MDOWN + j * SZ_MDOWN), 0, scr, r, lane, shm + 3 * 1024, SHW + (size_t)(L * 3 + 1) * 3 * 5632); return; }
        r -= I_MDOWN;
        if (r < I_MQUP) { xpose_item(ARGS.mla_w_q_up + (size_t)j * 768 * 1536, 768, 1536, (bf16*)(ws + OFF_MQUP + j * SZ_MQUP), 0, scr, r, lane); return; }
        r -= I_MQUP;
        if (r < I_MKVUP) { xpose_item(ARGS.mla_w_kv_up + (size_t)j * 256 * 2048, 256, 2048, (bf16*)(ws + OFF_MKVUP + j * SZ_MKVUP), 2, scr, r, lane); return; }
        r -= I_MKVUP;
        xpose_item(ARGS.mla_w_o + (size_t)j * DM * DM, DM, DM, (bf16*)(ws + OFF_MWO + j * SZ_WO), 0, scr, r, lane);
    }
}
constexpr int Q0_ITEMS = I_WOUT + I_DQKV + I_WO + I_WIN + I_WOUT;
constexpr int QUOTA_FFN_IN = 3456, QUOTA_FFN_OUT = 4608, QUOTA_OUT_PROJ = 2304, IDLE_FFN_IN = 880 - 768, IDLE_160 = 160;
__device__ __forceinline__ bool defer_ok() { return gridDim.x == 256; }
__device__ __forceinline__ void deferred_slot(LAS unsigned char* lds, int qpos, int quota, int idle0) {
    const int tid = opaque_tid(), lane = tid & 63, wave = __builtin_amdgcn_readfirstlane(tid >> 6);
    const int qtot = Q0_ITEMS + layer_items(1) + layer_items(2) + layer_items(3);
    const int qend = qpos + quota < qtot ? qpos + quota : qtot;
    const int nw = ((int)gridDim.x - idle0) * NWAVES, w = ((int)blockIdx.x - idle0) * NWAVES + wave;
    LAS float* scr = (LAS float*)(lds + wave * 16384);
    for (int q = qpos + w; q < qend; q += nw) {
        int L, r;
        if (q < Q0_ITEMS) { L = 0;
            if (q < I_WOUT) r = 2 * I_WIN + q;
            else if (q < I_WOUT + I_DQKV) r = 2 * I_WIN + 2 * I_WOUT + (q - I_WOUT);
            else if (q < I_WOUT + I_DQKV + I_WO) r = 2 * I_WIN + 2 * I_WOUT + I_DQKV + (q - I_WOUT - I_DQKV);
            else if (q < I_WOUT + I_DQKV + I_WO + I_WIN) r = I_WIN + (q - I_WOUT - I_DQKV - I_WO);
            else r = 2 * I_WIN + I_WOUT + (q - I_WOUT - I_DQKV - I_WO - I_WIN);
        } else { int qq = q - Q0_ITEMS; L = 1; if (qq >= layer_items(1)) { qq -= layer_items(1); L = 2; if (qq >= layer_items(2)) { qq -= layer_items(2); L = 3; } } r = qq; }
        xpose_layer_item(L, r, scr, lane);
    }
}

__device__ __forceinline__ void prologue(LAS unsigned char* lds, const int part) {
    const int tid = opaque_tid(), lane = tid & 63, wave = __builtin_amdgcn_readfirstlane(tid >> 6);
    unsigned char* ws = ARGS.ws;
    const int G = gridDim.x, bx = blockIdx.x;
    if (part == 0) {
        LAS float* sil = (LAS float*)lds;
        LAS float* red = (LAS float*)(lds + 12288);
        for (int i = tid; i < 3 * 1024; i += NTHREADS) { const int g = i >> 10, k = i & 1023; const float cv = g == 0 ? ARGS.c_ctx[k] : ARGS.c[(g - 1) * 1024 + k]; sil[i] = cv / (1.f + __expf(-cv)); }
        __syncthreads();
        float* mod = (float*)(ws + OFF_MOD);
        const int ln = lane < 36 ? lane : 35;
        for (int u = bx; u < 4 * 64; u += G) {
            const int l = u >> 6, n0 = (u & 63) * 144;
            const float* wp = ARGS.w_mod + ((size_t)l * 1024 + wave * 128) * NMOD + n0 + 4 * ln;
            f32x4 acc[3] = {{0.f, 0.f, 0.f, 0.f}, {0.f, 0.f, 0.f, 0.f}, {0.f, 0.f, 0.f, 0.f}};
#pragma unroll 1
            for (int kb = 0; kb < 128; kb += 16) {
                f32x4 w[16];
#pragma unroll
                for (int kk = 0; kk < 16; ++kk) w[kk] = *(const f32x4*)(wp + (size_t)(kb + kk) * NMOD);
#pragma unroll
                for (int kk = 0; kk < 16; ++kk) { const int k = wave * 128 + kb + kk;
#pragma unroll
                    for (int g = 0; g < 3; ++g) acc[g] += w[kk] * sil[g * 1024 + k]; }
            }
            if (lane < 36) {
#pragma unroll
                for (int g = 0; g < 3; ++g) *(LAS f32x4*)(red + (wave * 3 + g) * 144 + 4 * lane) = acc[g]; }
            __syncthreads();
            if (tid < 432) { const int g = tid / 144, cidx = tid - g * 144; float s = ARGS.b_mod[(size_t)l * NMOD + n0 + cidx];
#pragma unroll
                for (int w8 = 0; w8 < 8; ++w8) s += red[(w8 * 3 + g) * 144 + cidx];
                mod[((size_t)l * 3 + g) * NMOD + n0 + cidx] = s; }
            __syncthreads();
        }
    }
    if (part == 1) {
        LAS float* scr = (LAS float*)(lds + wave * 16384);
        const int gw = bx * NWAVES + wave, NGW = G * NWAVES;
        if (defer_ok()) { for (int r = gw; r < I_WIN; r += NGW) xpose_layer_item(0, r, scr, lane); }
        else for (int L = 0; L < 4; ++L) { const int n = layer_items(L);
            for (int r = gw; r < n; r += NGW) xpose_layer_item(L, r, scr, lane); }
    }
    if (part == 0) {
        const size_t gt = (size_t)bx * NTHREADS + tid, NT = (size_t)G * NTHREADS;
        for (size_t i = gt; i < (size_t)2 * 2 * 256 * 128; i += NT) {
            const int c8 = (int)(i & 127), s = (int)((i >> 7) & 255), j = (int)((i >> 15) & 1), b = (int)(i >> 16);
            const size_t src = (((size_t)(b * 2 + j) * 256 + s) * 1024) + c8 * 8, dst = (((size_t)j * 512 + b * 256 + s) * 1024) + c8 * 8;
            { const f32x4 a = *(const f32x4*)(ARGS.cache_diff_k + src), bb = *(const f32x4*)(ARGS.cache_diff_k + src + 4); float v[8] = {a.x, a.y, a.z, a.w, bb.x, bb.y, bb.z, bb.w}; *(u32x4*)((bf16*)(ws + OFF_KC) + dst) = pack8(v); }
            { const f32x4 a = *(const f32x4*)(ARGS.cache_diff_v + src), bb = *(const f32x4*)(ARGS.cache_diff_v + src + 4); float v[8] = {a.x, a.y, a.z, a.w, bb.x, bb.y, bb.z, bb.w}; *(u32x4*)((bf16*)(ws + OFF_VC) + dst) = pack8(v); }
        }
        for (size_t i = gt; i < (size_t)2 * 2 * 256 * 32; i += NT) {
            const int c8 = (int)(i & 31), s = (int)((i >> 5) & 255), j = (int)((i >> 13) & 1), b = (int)(i >> 14);
            const size_t src = (((size_t)(b * 2 + j) * 256 + s) * 256) + c8 * 8;
            const f32x4 a = *(const f32x4*)(ARGS.cache_mla_ckv + src), bb = *(const f32x4*)(ARGS.cache_mla_ckv + src + 4); float v[8] = {a.x, a.y, a.z, a.w, bb.x, bb.y, bb.z, bb.w};
            *(u32x4*)((bf16*)(ws + OFF_CKV + j * SZ_CKV) + ((size_t)(NTOK + b * 256 + s) * 256) + c8 * 8) = pack8(v);
        }
        for (size_t i = gt; i < (size_t)2 * 2 * 256; i += NT) {
            const int s = (int)(i & 255), j = (int)((i >> 8) & 1), b = (int)(i >> 9);
            const float* src = ARGS.cache_mla_kpe + ((size_t)(b * 2 + j) * 256 + s) * 32;
            float* dst = (float*)(ws + OFF_KPE + j * SZ_KPE) + (size_t)(NTOK + b * 256 + s) * 32;
            float ss = 0.f;
            for (int e = 0; e < 32; ++e) { const float v = src[e]; dst[e] = v * ARGS.mla_k_norm[j * 96 + 64 + e]; ss += v * v; }
            ((float*)(ws + OFF_KPSS + j * SZ_KPSS))[NTOK + b * 256 + s] = ss;
        }
        for (size_t i = gt; i < (size_t)2 * 224 * 128; i += NT) {
            const int c8 = (int)(i & 127), r = (int)((i >> 7) % 224), w = (int)(i / (224 * 128));
            *(u32x4*)((bf16*)(ws + OFF_MDOWN + w * SZ_MDOWN) + (size_t)(1056 + r) * 1024 + c8 * 8) = (u32x4){0u, 0u, 0u, 0u};
        }
        for (size_t i = gt; i < (size_t)12 * 3 * 5632 / 4; i += NT) *(f32x4*)((float*)(ws + OFF_SHW) + 4 * i) = (f32x4){0.f, 0.f, 0.f, 0.f};
        for (size_t i = gt; i < (size_t)12 * NTOK / 4; i += NT) *(f32x4*)((float*)(ws + OFF_SS) + 4 * i) = (f32x4){0.f, 0.f, 0.f, 0.f};
        for (size_t i = gt; i < 64 * 16 + 64 * 8; i += NT) {
            const bool isD = i < 64 * 16; const int idx = isD ? (int)i : (int)i - 64 * 16;
            const int pos = isD ? idx >> 4 : idx >> 3, f = isD ? idx & 15 : idx & 7;
            const float freq = __builtin_amdgcn_exp2f(-(isD ? (float)f / 16.f : (float)f / 8.f) * 13.287712379549449f);
            float rev = (float)pos * freq * 0.15915494309189535f; rev -= floorf(rev);
            const float cs = __builtin_amdgcn_cosf(rev), sn = __builtin_amdgcn_sinf(rev);
            float* tb = isD ? (float*)(ws + OFF_TABD) : (float*)(ws + OFF_TABM);
            tb[2 * idx] = cs; tb[2 * idx + 1] = sn;
        }
    }

    if (part == 1) {
        const float* mod = (const float*)(ws + OFF_MOD);
        const float* g = ARGS.norm_g; bf16* H = (bf16*)(ws + OFF_H); float* SS = (float*)(ws + OFF_SS);
        const int gw = bx * NWAVES + wave, NGW = G * NWAVES;
        constexpr int RB = 5;
        for (int row0 = gw; row0 < NTOK; row0 += RB * NGW) {
            f32x4 v[RB][4];
#pragma unroll
            for (int r = 0; r < RB; ++r) { const int row = row0 + r * NGW < NTOK ? row0 + r * NGW : gw;
                const float* xr = row < NCTX ? ARGS.x_prompt + (size_t)row * DM : ARGS.x_sample + (size_t)(row - NCTX) * DM;
#pragma unroll
                for (int jj = 0; jj < 4; ++jj) v[r][jj] = *(const f32x4*)(xr + 4 * lane + 256 * jj); }
#pragma unroll
            for (int r = 0; r < RB; ++r) { const int row = row0 + r * NGW;
                if (row < NTOK) {
                    const float* md = mod + (size_t)tok_group(row) * NMOD + 1024;
                    float ss = 0.f;
#pragma unroll
                    for (int jj = 0; jj < 4; ++jj) { const int c = 4 * lane + 256 * jj; const f32x4 x4 = v[r][jj], gg = *(const f32x4*)(g + c), sc = *(const f32x4*)(md + c);
                        ss += x4.x * x4.x + x4.y * x4.y + x4.z * x4.z + x4.w * x4.w;
                        *(u32x2*)(H + (size_t)row * DM + c) = (u32x2){pk2(x4.x * gg.x * (1.f + sc.x), x4.y * gg.y * (1.f + sc.y)), pk2(x4.z * gg.z * (1.f + sc.z), x4.w * gg.w * (1.f + sc.w))}; }
                    ss = wave_sum(ss);
                    if (lane == 0) SS[row] = ss;
                }
            }
        }
    }
}

__device__ __forceinline__ void init_phase(LAS unsigned char* lds) {
    const int tid = opaque_tid(), lane = tid & 63, wave = __builtin_amdgcn_readfirstlane(tid >> 6);
    unsigned char* ws = ARGS.ws;
    const float* mod = (const float*)(ws + OFF_MOD);
    const int gw = blockIdx.x * NWAVES + wave, NGW = gridDim.x * NWAVES;
    {
        const float* g = ARGS.norm_g; bf16* H = (bf16*)(ws + OFF_H); float* SS = (float*)(ws + OFF_SS);
        for (int row = gw; row < NTOK; row += NGW) {
            const float* xr = row < NCTX ? ARGS.x_prompt + (size_t)row * DM : ARGS.x_sample + (size_t)(row - NCTX) * DM;
            const float* md = mod + (size_t)tok_group(row) * NMOD + 1024;
            float ss = 0.f;
#pragma unroll
            for (int jj = 0; jj < 4; ++jj) { const int c = 4 * lane + 256 * jj; const f32x4 v = *(const f32x4*)(xr + c), gg = *(const f32x4*)(g + c), sc = *(const f32x4*)(md + c);
                ss += v.x * v.x + v.y * v.y + v.z * v.z + v.w * v.w;
                *(u32x2*)(H + (size_t)row * DM + c) = (u32x2){pk2(v.x * gg.x * (1.f + sc.x), v.y * gg.y * (1.f + sc.y)), pk2(v.z * gg.z * (1.f + sc.z), v.w * gg.w * (1.f + sc.w))}; }
            ss = wave_sum(ss);
            if (lane == 0) SS[row] = ss;
        }
    }
    {
        float* SHW = (float*)(ws + OFF_SHW);
        for (int l = 0; l < 4; ++l) {
            const int j = l >> 1, NM = (l & 1) ? 1280 : 3072, tot = 2 * 5632 + NM;
            for (int r = gw; r < tot; r += NGW) {
                int which, n; const bf16* Bt;
                if (r < 5632) { which = 0; n = r; Bt = (const bf16*)(ws + OFF_WIN + (size_t)(l * 2) * SZ_WIN); }
                else if (r < 2 * 5632) { which = 2; n = r - 5632; Bt = (const bf16*)(ws + OFF_WIN + (size_t)(l * 2 + 1) * SZ_WIN); }
                else { which = 1; n = r - 2 * 5632; Bt = (l & 1) ? (const bf16*)(ws + OFF_MDOWN + j * SZ_MDOWN) : (const bf16*)(ws + OFF_DQKV + j * SZ_DQKV); }
                const bf16* wr_ = Bt + (size_t)n * DM;
                const bf16x8 w0 = *(const bf16x8*)(wr_ + 8 * lane), w1 = *(const bf16x8*)(wr_ + 512 + 8 * lane);
                const float* sh = mod + (size_t)l * 3 * NMOD + (size_t)(3 * which) * 1024;
                float a[3];
#pragma unroll
                for (int g = 0; g < 3; ++g) { const float* s = sh + (size_t)g * NMOD; float acc = 0.f;
                    const f32x4 s0 = *(const f32x4*)(s + 8 * lane), s1 = *(const f32x4*)(s + 8 * lane + 4), s2 = *(const f32x4*)(s + 512 + 8 * lane), s3 = *(const f32x4*)(s + 512 + 8 * lane + 4);
                    acc += bf2f((unsigned short)w0[0]) * s0.x + bf2f((unsigned short)w0[1]) * s0.y + bf2f((unsigned short)w0[2]) * s0.z + bf2f((unsigned short)w0[3]) * s0.w;
                    acc += bf2f((unsigned short)w0[4]) * s1.x + bf2f((unsigned short)w0[5]) * s1.y + bf2f((unsigned short)w0[6]) * s1.z + bf2f((unsigned short)w0[7]) * s1.w;
                    acc += bf2f((unsigned short)w1[0]) * s2.x + bf2f((unsigned short)w1[1]) * s2.y + bf2f((unsigned short)w1[2]) * s2.z + bf2f((unsigned short)w1[3]) * s2.w;
                    acc += bf2f((unsigned short)w1[4]) * s3.x + bf2f((unsigned short)w1[5]) * s3.y + bf2f((unsigned short)w1[6]) * s3.z + bf2f((unsigned short)w1[7]) * s3.w;
                    a[g] = wave_sum(acc); }
                if (lane < 3) SHW[((size_t)(l * 3 + which) * 3 + lane) * 5632 + n] = lane == 0 ? a[0] : (lane == 1 ? a[1] : a[2]);
            }
        }
    }
}
__device__ __forceinline__ void mla_norm_phase(int j) {
    const int tid = opaque_tid(), lane = tid & 63, wave = __builtin_amdgcn_readfirstlane(tid >> 6);
    unsigned char* ws = ARGS.ws;
    const float* DOWN = (const float*)(ws + OFF_DOWN); bf16* CQ = (bf16*)(ws + OFF_CQ); bf16* CKV = (bf16*)(ws + OFF_CKV + j * SZ_CKV);
    float* KPE = (float*)(ws + OFF_KPE + j * SZ_KPE); float* KPSS = (float*)(ws + OFF_KPSS + j * SZ_KPSS);
    const float* qag = ARGS.mla_q_a_norm + j * 768; const float* kvag = ARGS.mla_kv_a_norm + j * 256;
    const int gw = blockIdx.x * NWAVES + wave, NGW = gridDim.x * NWAVES;
    const f32x4 kg4 = *(const f32x4*)(kvag + 4 * lane);
    const float kpg = lane < 32 ? ARGS.mla_k_norm[j * 96 + 64 + lane] : 0.f;
    f32x4 qg4[3];
#pragma unroll
    for (int jj = 0; jj < 3; ++jj) qg4[jj] = *(const f32x4*)(qag + 4 * lane + 256 * jj);
    constexpr int RB = 5;
    for (int row0 = gw; row0 < NTOK; row0 += RB * NGW) {
        f32x4 v[RB][3], kv[RB]; float pe[RB];
#pragma unroll
        for (int r = 0; r < RB; ++r) { const int row = row0 + r * NGW; const float* dr = DOWN + (size_t)(row < NTOK ? row : gw) * 1056;
#pragma unroll
            for (int jj = 0; jj < 3; ++jj) v[r][jj] = *(const f32x4*)(dr + 4 * lane + 256 * jj);
            kv[r] = *(const f32x4*)(dr + 768 + 4 * lane);
            pe[r] = lane < 32 ? dr[1024 + lane] : 0.f; }
#pragma unroll
        for (int r = 0; r < RB; ++r) { const int row = row0 + r * NGW;
            if (row < NTOK) {
                float ss = 0.f;
#pragma unroll
                for (int jj = 0; jj < 3; ++jj) ss += v[r][jj].x * v[r][jj].x + v[r][jj].y * v[r][jj].y + v[r][jj].z * v[r][jj].z + v[r][jj].w * v[r][jj].w;
                const float rq = __builtin_amdgcn_rsqf(wave_sum(ss) * (1.f / 768.f) + EPS);
#pragma unroll
                for (int jj = 0; jj < 3; ++jj) { const int c = 4 * lane + 256 * jj; const f32x4 gg = qg4[jj];
                    *(u32x2*)(CQ + (size_t)row * 768 + c) = (u32x2){pk2(v[r][jj].x * rq * gg.x, v[r][jj].y * rq * gg.y), pk2(v[r][jj].z * rq * gg.z, v[r][jj].w * rq * gg.w)}; }
                const f32x4 k4 = kv[r];
                const float rk = __builtin_amdgcn_rsqf(wave_sum(k4.x * k4.x + k4.y * k4.y + k4.z * k4.z + k4.w * k4.w) * (1.f / 256.f) + EPS);
                const f32x4 kn = (f32x4){k4.x * rk * kg4.x, k4.y * rk * kg4.y, k4.z * rk * kg4.z, k4.w * rk * kg4.w};
                *(u32x2*)(CKV + (size_t)row * 256 + 4 * lane) = (u32x2){pk2(kn.x, kn.y), pk2(kn.z, kn.w)};
                const float pss = wave_sum(pe[r] * pe[r]);
                if (lane < 32) KPE[(size_t)row * 32 + lane] = pe[r] * kpg;
                if (lane == 0) KPSS[row] = pss;
                if (row < NCTX) { const int b = row >> 8, s = row & 255;
                    *(f32x4*)(ARGS.out + OUT_CKV + ((size_t)(b * 2 + j) * 256 + s) * 256 + 4 * lane) = kn;
                    if (lane < 32) ARGS.out[OUT_KPE + ((size_t)(b * 2 + j) * 256 + s) * 32 + lane] = pe[r]; }
            }
        }
    }
}

struct AttnArgs {
    const bf16* Q; int qpitch;
    const bf16* K; int kpitch;
    const bf16* V; int vpitch;
    const bf16* Kc; const bf16* Vc;
    bf16* O;
    const float* qg;
    const float* tabM;
    const float* subln;
    float lam, one_m_lam_init, scale_log2;
    unsigned* ctr;
    int nheads;
};

template <int NC, int DK, int DV, bool MLA, int QT>
__device__ __forceinline__ void attn_phase(LAS unsigned char* lds, const AttnArgs& a) {
    const int tid = opaque_tid(), lane = tid & 63, wave = __builtin_amdgcn_readfirstlane(tid >> 6);
    constexpr int KB = NC * DK * 2, VB = DV * 2;
    constexpr int KP = 272, VP = 288;
    constexpr bool VSWZ = true;
    constexpr int KPR = KB / 16, VPR = VB / 16, NPIECE = 64 * (KPR + VPR), NST = (NPIECE + NTHREADS - 1) / NTHREADS;
    constexpr int KS = DK / 32, DC = DV / 16;
    LAS unsigned char* ldsK = lds; LAS unsigned char* ldsV = lds + 64 * KP;
    volatile LAS int* uslot = (volatile LAS int*)(lds + 64 * KP + 64 * VP);
    const int fr = lane & 15, g = lane >> 4;
    constexpr int LQB = 8 / QT, CQB = 2 / QT;
    const int nlat = 2 * a.nheads * LQB, nctx = 32 * a.nheads * CQB, nunits = nlat + nctx;
    const bool stat = (gridDim.x == 256) && nlat == 128 && nctx == 512;
    for (int it = 0;; ++it) {
        int u;
        if (stat) { const int bxs = (int)blockIdx.x; u = bxs < 128 ? (it == 0 ? bxs : nunits) : (it < 4 ? 128 + 4 * (bxs - 128) + it : nunits); }
        else {
            __syncthreads();
            if (tid == 0) *uslot = (int)atomicAdd(a.ctr, 1u);
            __syncthreads();
            u = *uslot;
        }
        if (u >= nunits) break;
        int b, h, qb, nch, qrow0; const bf16 *kc0, *vc0, *kn0, *vn0; bool lat;
        if (u < nlat) { lat = true; b = u / (a.nheads * LQB); const int r = u % (a.nheads * LQB); h = r / LQB; qb = r % LQB; nch = 20; qrow0 = NCTX + b * 1024 + qb * 128 * QT;
            kc0 = a.Kc + (size_t)(b * 256) * a.kpitch; vc0 = a.Vc + (size_t)(b * 256) * a.vpitch; kn0 = a.K + (size_t)(NCTX + b * 1024) * a.kpitch; vn0 = a.V + (size_t)(NCTX + b * 1024) * a.vpitch; }
        else { lat = false; const int uu = u - nlat; b = uu / (a.nheads * CQB); const int r = uu % (a.nheads * CQB); h = r / CQB; qb = r % CQB; nch = 4; qrow0 = b * 256 + qb * 128 * QT;
            kc0 = a.K + (size_t)(b * 256) * a.kpitch; vc0 = a.V + (size_t)(b * 256) * a.vpitch; kn0 = kc0; vn0 = vc0; }
        bf16x8 qf[QT][NC][KS];
#pragma unroll
        for (int qt = 0; qt < QT; ++qt) {
        const int qrow = qrow0 + wave * 16 * QT + qt * 16 + fr;
        if constexpr (!MLA) {
#pragma unroll
            for (int c = 0; c < NC; ++c)
#pragma unroll
                for (int ks = 0; ks < KS; ++ks) qf[qt][c][ks] = *(const bf16x8*)(a.Q + (size_t)qrow * a.qpitch + (h * NC + c) * DK + 32 * ks + 8 * g);
        } else {
            float x[KS][8]; float ss = 0.f;
#pragma unroll
            for (int ks = 0; ks < KS; ++ks) { const bf16x8 raw = *(const bf16x8*)(a.Q + (size_t)qrow * a.qpitch + h * DK + 32 * ks + 8 * g);
#pragma unroll
                for (int i = 0; i < 8; ++i) { x[ks][i] = bf2f((unsigned short)raw[i]); ss += x[ks][i] * x[ks][i]; } }
            ss = quad_sum(ss);
            const float rstd = __builtin_amdgcn_rsqf(ss * (1.f / DK) + EPS);
#pragma unroll
            for (int ks = 0; ks < KS; ++ks)
#pragma unroll
                for (int i = 0; i < 8; ++i) x[ks][i] = x[ks][i] * rstd * a.qg[32 * ks + 8 * g + i];
            if (lat) {
                const int t = (qrow - NCTX) & 1023, pos = (g >> 1) ? (t & 63) : (t >> 6);
                const float* tb = a.tabM + (size_t)pos * 16;
#pragma unroll
                for (int i = 0; i < 8; ++i) { const float p = __shfl_xor(x[KS - 1][i], 16), cs = tb[2 * i], sn = tb[2 * i + 1];
                    x[KS - 1][i] = (g & 1) == 0 ? x[KS - 1][i] * cs - p * sn : x[KS - 1][i] * cs + p * sn; }
            }
#pragma unroll
            for (int ks = 0; ks < KS; ++ks) qf[qt][0][ks] = __builtin_bit_cast(bf16x8, pack8(x[ks]));
        }
        }
        float mrun[QT][NC], lrun[QT][NC]; f32x4 o[QT][NC][DC];
#pragma unroll
        for (int qt = 0; qt < QT; ++qt)
#pragma unroll
        for (int c = 0; c < NC; ++c) { mrun[qt][c] = -1e30f; lrun[qt][c] = 0.f;
#pragma unroll
            for (int dc = 0; dc < DC; ++dc) o[qt][c][dc] = (f32x4){0.f, 0.f, 0.f, 0.f}; }
        constexpr int NKP = 64 * KPR, NVP = 64 * VPR, NKL = (NKP + NTHREADS - 1) / NTHREADS, NVL = NVP / NTHREADS;
        static_assert(NVP % NTHREADS == 0 && NKL * NTHREADS <= 2 * NKP, "staging piece map");
        constexpr int DEPTH = MLA ? 4 : 2;
        u32x4 st[DEPTH][NKL + NVL];
        const int kcol = h * NC * DK, vcol = h * DV;
#define ATT_PREFETCH(ch, SB) do { const int key0 = (ch) * 64; const bf16* kb_ = key0 < 256 ? kc0 + (size_t)key0 * a.kpitch : kn0 + (size_t)(key0 - 256) * a.kpitch; \
            const bf16* vb_ = key0 < 256 ? vc0 + (size_t)key0 * a.vpitch : vn0 + (size_t)(key0 - 256) * a.vpitch; \
            _Pragma("unroll") for (int s_ = 0; s_ < NKL; ++s_) { const int p0_ = tid + s_ * NTHREADS, p_ = p0_ < NKP ? p0_ : p0_ - NKP; const int r_ = p_ / KPR, c_ = p_ % KPR; \
                st[SB][s_] = *(const u32x4*)(kb_ + (size_t)r_ * a.kpitch + kcol + c_ * 8); } \
            _Pragma("unroll") for (int s_ = 0; s_ < NVL; ++s_) { const int q_ = tid + s_ * NTHREADS, r_ = q_ / VPR, c_ = q_ % VPR; \
                st[SB][NKL + s_] = *(const u32x4*)(vb_ + (size_t)r_ * a.vpitch + vcol + c_ * 8); } } while (0)
#define ATT_COMMIT(SB) do { \
            _Pragma("unroll") for (int s_ = 0; s_ < NKL; ++s_) { const int p0_ = tid + s_ * NTHREADS, p_ = p0_ < NKP ? p0_ : p0_ - NKP; const int r_ = p_ / KPR, c_ = p_ % KPR; \
                *(LAS u32x4*)(ldsK + r_ * KP + (c_ ^ (((r_ >> 4) & 1) << 2)) * 16) = st[SB][s_]; } \
            _Pragma("unroll") for (int s_ = 0; s_ < NVL; ++s_) { const int q_ = tid + s_ * NTHREADS, r_ = q_ / VPR, c_ = q_ % VPR; \
                *(LAS u32x4*)(ldsV + r_ * VP + (VSWZ ? (c_ ^ (((r_ >> 3) & 1) << 3)) : c_) * 16) = st[SB][NKL + s_]; } } while (0)
#pragma unroll
        for (int hb = 0; hb < DEPTH; ++hb) ATT_PREFETCH(hb, hb);
        for (int ch2 = 0; ch2 < nch; ch2 += DEPTH) {
#pragma unroll
          for (int hb = 0; hb < DEPTH; ++hb) {
            const int ch = ch2 + hb;
            __syncthreads();
            ATT_COMMIT(hb);
            __syncthreads();
            { const int chp = ch + DEPTH < nch ? ch + DEPTH : nch - 1;
              ATT_PREFETCH(chp, hb); }
            bf16x8 pb[QT][NC][2];
#pragma unroll
            for (int c = 0; c < NC; ++c) {
                f32x4 sq[QT][4];
#pragma unroll
                for (int kt = 0; kt < 4; ++kt) {
#pragma unroll
                    for (int qt = 0; qt < QT; ++qt) sq[qt][kt] = (f32x4){0.f, 0.f, 0.f, 0.f};
                    const int keyrow = 32 * (kt >> 1) + 8 * (fr >> 2) + 4 * (kt & 1) + (fr & 3);
#pragma unroll
                    for (int ks = 0; ks < KS; ++ks) { const bf16x8 kf = *(const LAS bf16x8*)(ldsK + keyrow * KP + (((c * DK * 2 + ks * 64) / 16 + g) ^ (((fr >> 3) & 1) << 2)) * 16);
#pragma unroll
                        for (int qt = 0; qt < QT; ++qt) sq[qt][kt] = __builtin_amdgcn_mfma_f32_16x16x32_bf16(kf, qf[qt][c][ks], sq[qt][kt], 0, 0, 0); }
                }
#pragma unroll
                for (int qt = 0; qt < QT; ++qt) {
                f32x4 (&s)[4] = sq[qt];
                float mx = -1e30f;
#pragma unroll
                for (int kt = 0; kt < 4; ++kt) mx = fmaxf(mx, fmaxf(fmaxf(s[kt].x, s[kt].y), fmaxf(s[kt].z, s[kt].w)));
                mx = quad_max(mx) * a.scale_log2;
                const bool need = mx > mrun[qt][c] + 8.f;
                if (__builtin_amdgcn_ballot_w64(need) != 0ull) {
                    const float mnew = need ? mx : mrun[qt][c], alpha = __builtin_amdgcn_exp2f(mrun[qt][c] - mnew);
                    lrun[qt][c] *= alpha; mrun[qt][c] = mnew;
#pragma unroll
                    for (int dc = 0; dc < DC; ++dc) o[qt][c][dc] = o[qt][c][dc] * alpha;
                }
                const float nm = -mrun[qt][c], sc2 = a.scale_log2;
                float rs = 0.f;
#pragma unroll
                for (int kt = 0; kt < 4; ++kt) { s[kt].x = __builtin_amdgcn_exp2f(__builtin_fmaf(s[kt].x, sc2, nm)); s[kt].y = __builtin_amdgcn_exp2f(__builtin_fmaf(s[kt].y, sc2, nm));
                    s[kt].z = __builtin_amdgcn_exp2f(__builtin_fmaf(s[kt].z, sc2, nm)); s[kt].w = __builtin_amdgcn_exp2f(__builtin_fmaf(s[kt].w, sc2, nm));
                    rs += (s[kt].x + s[kt].y) + (s[kt].z + s[kt].w); }
                rs = quad_sum(rs);
                lrun[qt][c] += rs;
#pragma unroll
                for (int t = 0; t < 2; ++t) { u32x4 w; w.x = pk2(s[2 * t].x, s[2 * t].y); w.y = pk2(s[2 * t].z, s[2 * t].w); w.z = pk2(s[2 * t + 1].x, s[2 * t + 1].y); w.w = pk2(s[2 * t + 1].z, s[2 * t + 1].w);
                    pb[qt][c][t] = __builtin_bit_cast(bf16x8, w); }
                }
            }
#pragma unroll
            for (int t = 0; t < 2; ++t) { __builtin_amdgcn_sched_barrier(0);
#pragma unroll
                for (int dc = 0; dc < DC; ++dc) {
                    const int vslot = 2 * dc + ((fr & 3) >> 1);
                    const LAS unsigned char* vp = ldsV + (32 * t + 8 * g + (fr >> 2)) * VP + (VSWZ ? (vslot ^ ((g & 1) << 3)) : vslot) * 16 + (fr & 1) * 8;
                    const s16x4 lo = __builtin_bit_cast(s16x4, __builtin_amdgcn_ds_read_tr16_b64_v4i16((LAS s16x4*)vp));
                    const s16x4 hi = __builtin_bit_cast(s16x4, __builtin_amdgcn_ds_read_tr16_b64_v4i16((LAS s16x4*)(vp + 4 * VP)));
                    bf16x8 vf; vf[0] = lo[0]; vf[1] = lo[1]; vf[2] = lo[2]; vf[3] = lo[3]; vf[4] = hi[0]; vf[5] = hi[1]; vf[6] = hi[2]; vf[7] = hi[3];
#pragma unroll
                    for (int qt = 0; qt < QT; ++qt)
#pragma unroll
                    for (int c = 0; c < NC; ++c) o[qt][c][dc] = __builtin_amdgcn_mfma_f32_16x16x32_bf16(vf, pb[qt][c][t], o[qt][c][dc], 0, 0, 0);
                } }
          }
        }
#undef ATT_PREFETCH
#undef ATT_COMMIT
#pragma unroll
        for (int qt = 0; qt < QT; ++qt) {
        const int qrow = qrow0 + wave * 16 * QT + qt * 16 + fr;
        bf16* orow = a.O + (size_t)qrow * 1024 + h * DV + 4 * g;
        if constexpr (!MLA) {
            const float i0 = __builtin_amdgcn_rcpf(lrun[qt][0]), i1 = a.lam * __builtin_amdgcn_rcpf(lrun[qt][NC - 1]);
            float ss = 0.f;
#pragma unroll
            for (int dc = 0; dc < DC; ++dc) { o[qt][0][dc] = o[qt][0][dc] * i0 - o[qt][NC - 1][dc] * i1; ss += o[qt][0][dc].x * o[qt][0][dc].x + o[qt][0][dc].y * o[qt][0][dc].y + o[qt][0][dc].z * o[qt][0][dc].z + o[qt][0][dc].w * o[qt][0][dc].w; }
            ss = quad_sum(ss);
            const float rstd = __builtin_amdgcn_rsqf(ss * (1.f / DV) + EPS) * a.one_m_lam_init;
#pragma unroll
            for (int dc = 0; dc < DC; ++dc) { const f32x4 sg = *(const f32x4*)(a.subln + 16 * dc + 4 * g);
                *(u32x2*)(orow + 16 * dc) = (u32x2){pk2(o[qt][0][dc].x * rstd * sg.x, o[qt][0][dc].y * rstd * sg.y), pk2(o[qt][0][dc].z * rstd * sg.z, o[qt][0][dc].w * rstd * sg.w)}; }
        } else {
            const float i0 = __builtin_amdgcn_rcpf(lrun[qt][0]);
#pragma unroll
            for (int dc = 0; dc < DC; ++dc) *(u32x2*)(orow + 16 * dc) = (u32x2){pk2(o[qt][0][dc].x * i0, o[qt][0][dc].y * i0), pk2(o[qt][0][dc].z * i0, o[qt][0][dc].w * i0)};
        }
        }
    }
}

#define XB_TMO      128
#define XB_XCNT(j)  (256  + 64 * (j))
#define XB_XSUB(j)  (1280 + 64 * (j))
#define XB_XGEN(j)  (2304 + 64 * (j))
#define XB_TOP      3328
#define XB_TOPGEN   3392
#define XCD_BAR_WORDS 3456
#define XB_SPIN_CAP (1u << 18)

__device__ __forceinline__ unsigned xb_ld(unsigned* p)              { return __hip_atomic_load(p, __ATOMIC_RELAXED, __HIP_MEMORY_SCOPE_AGENT); }
__device__ __forceinline__ unsigned xb_add(unsigned* p, unsigned v) { return __hip_atomic_fetch_add(p, v, __ATOMIC_RELAXED, __HIP_MEMORY_SCOPE_AGENT); }
__device__ __forceinline__ unsigned xb_xcc_id() { return (unsigned)__builtin_amdgcn_s_getreg((3 << 11) | 20) & 0xFu; }
#define XB_SPIN(cond, bar) do { unsigned _sp = 0; while (cond) { __builtin_amdgcn_s_sleep(1); \
    if ((++_sp & 255u) == 0u) { if (xb_ld(&(bar)[XB_TMO])) break; if (_sp > XB_SPIN_CAP) { atomicAdd(&(bar)[XB_TMO], 1u); break; } } } } while (0)

struct XcdBarrier {
    unsigned* bar; unsigned x;
    volatile LAS unsigned* st;
};

__device__ __forceinline__ XcdBarrier xcd_barrier_post(unsigned* bar, volatile LAS unsigned* st) {
    XcdBarrier b; b.bar = bar; b.x = xb_xcc_id(); b.st = st;
    if (threadIdx.x == 0) (void)xb_add(&bar[XB_XCNT(b.x)], 1u);
    return b;
}
__device__ __forceinline__ void xcd_barrier_complete(unsigned* bar, unsigned x, unsigned& nloc, unsigned& nx) {
    const unsigned G = gridDim.x * gridDim.y * gridDim.z;
    unsigned sum, cnt, mine, sp = 0u;
    for (;;) {
        sum = 0u; cnt = 0u; mine = 0u;
#pragma unroll
        for (unsigned j = 0; j < 16; ++j) { const unsigned c = xb_ld(&bar[XB_XCNT(j)]); sum += c; cnt += (c > 0u) ? 1u : 0u; mine = (j == x) ? c : mine; }
        if (sum == G) break;
        __builtin_amdgcn_s_sleep(1);
        if ((++sp & 255u) == 0u) { if (xb_ld(&bar[XB_TMO])) break; if (sp > XB_SPIN_CAP) { atomicAdd(&bar[XB_TMO], 1u); break; } }
    }
    nloc = mine > 0u ? mine : 1u; nx = cnt > 0u ? cnt : 1u;
}

__device__ __forceinline__ void xcd_barrier(const XcdBarrier& b) {
    asm volatile("s_waitcnt vmcnt(0)" ::: "memory");
    __syncthreads();
    if (threadIdx.x == 0) {
        unsigned* bar = b.bar;
        __builtin_amdgcn_s_waitcnt(0);
        unsigned nloc = b.st[0], nx = b.st[1];
        if (nloc == 0u) { xcd_barrier_complete(bar, b.x, nloc, nx); b.st[0] = nloc; b.st[1] = nx; }
        const unsigned old = xb_add(&bar[XB_XSUB(b.x)], 1u);
        const unsigned gen = old / nloc;
        if (old + 1u == (gen + 1u) * nloc) {
            __builtin_amdgcn_fence(__ATOMIC_RELEASE, "agent");
            asm volatile("s_waitcnt vmcnt(0)" ::: "memory");
            const unsigned og = xb_add(&bar[XB_TOP], 1u);
            const unsigned tg = og / nx;
            asm volatile("buffer_inv sc1" ::: "memory");
            if (og + 1u == (tg + 1u) * nx) xb_add(&bar[XB_TOPGEN], 1u);
            else XB_SPIN(xb_ld(&bar[XB_TOPGEN]) == tg, bar);
            asm volatile("" ::: "memory");
            xb_add(&bar[XB_XGEN(b.x)], 1u);
            asm volatile("s_waitcnt vmcnt(0)" ::: "memory");
        } else {
            asm volatile("buffer_inv sc1" ::: "memory");
            XB_SPIN(xb_ld(&bar[XB_XGEN(b.x)]) == gen, bar);
            asm volatile("" ::: "memory");
            asm volatile("s_waitcnt vmcnt(0)" ::: "memory");
        }
    }
    __syncthreads();
}

__global__ void __launch_bounds__(NTHREADS, 2) mega_fwd(Args A_kernarg) {
    extern __shared__ __attribute__((aligned(16))) unsigned char lds_raw[];
    LAS unsigned char* lds = (LAS unsigned char*)lds_raw;
    cg::grid_group grid = cg::this_grid();
    { const int t0 = threadIdx.x; if (t0 < 64) ((LAS unsigned*)(lds + 131072))[t0] = 0u; }
    __syncthreads();
    (void)xcd_barrier_post((unsigned*)(ARGS.ws + OFF_CTL) + 4096, (volatile LAS unsigned*)(lds + 131072 + 32));
#define GSYNC1() do { XcdBarrier b_; b_.bar = (unsigned*)(ws + OFF_CTL) + 4096; b_.x = xb_xcc_id(); b_.st = (volatile LAS unsigned*)(lds + 131072 + 32); xcd_barrier(b_); } while (0)
#ifdef PROBE_SYNC
#define GSYNC() do { GSYNC1(); GSYNC1(); } while (0)
#else
#define GSYNC() GSYNC1()
#endif
    const int G = gridDim.x, bx = blockIdx.x;
    int qpos = 0;
#define ws (ARGS.ws)
#define out (ARGS.out)
#define mod ((const float*)(ws + OFF_MOD))
#define H ((bf16*)(ws + OFF_H))
#define ACT ((bf16*)(ws + OFF_ACT))
#define QB ((bf16*)(ws + OFF_Q))
#define KBUF ((bf16*)(ws + OFF_K))
#define VBUF ((bf16*)(ws + OFF_V))
#define OB ((bf16*)(ws + OFF_O))
#define ctl ((unsigned*)(ws + OFF_CTL))
#define SSLOT(s) ((float*)(ws + OFF_SS) + (size_t)(s) * NTOK)
#define SHWSLOT(s) ((const float*)(ws + OFF_SHW) + (size_t)(s) * 3 * 5632)


    prologue(lds, 0);
    if (out == nullptr) grid.sync();
    GSYNC();
    prologue(lds, 1);
    GSYNC();

#pragma unroll 1
    for (int l = 0; l < 4; ++l) {
        const int j = l >> 1;
#define modl (mod + (size_t)l * 3 * NMOD)
#define xp (l == 0 ? ARGS.x_prompt : (const float*)out)
#define xs (l == 0 ? ARGS.x_sample : (const float*)(out + (size_t)NCTX * DM))
#define xso (out + (size_t)NCTX * DM)
#pragma unroll 1
        for (int f = 0; f < 2; ++f) {
            if (f == 1) {
                if ((l & 1) == 0) {
                    { pg8::Gemm gm{H, (const bf16*)(ws + OFF_DQKV + j * SZ_DQKV), NTOK, 3072, DM}; pg8::StaticOrder S; S.init(NTOK, 3072, G, bx);
                      EpiDiffQKV E{QB, KBUF, VBUF, ARGS.diff_q_norm + j * 64, ARGS.diff_k_norm + j * 64, (const float*)(ws + OFF_TABD), out + OUT_DK, out + OUT_DV, j, SSLOT(l * 3 + 1), SHWSLOT(l * 3 + 1)};

#if !defined(ONLY) || ONLY == 1
      pg8::gemm_phase<EpiDiffQKV, pg8::StaticOrder, true, true>(lds, gm, S, E);
#endif
 }
                    GSYNC();
                    { const float* lp = ARGS.diff_lambda + j * 256; const int lane = opaque_tid() & 63;
                      const float s1 = wave_sum(lp[lane] * lp[64 + lane]), s2 = wave_sum(lp[128 + lane] * lp[192 + lane]);
                      int l_o = l; asm volatile("" : "+s"(l_o)); const float lam_init = l_o == 0 ? 0.2f : 0.47071301834358418f;
                      const float lam = __expf(s1) - __expf(s2) + lam_init;
                      AttnArgs a{QB, 1024, KBUF, 1024, VBUF, 1024, (const bf16*)(ws + OFF_KC) + (size_t)j * 512 * 1024, (const bf16*)(ws + OFF_VC) + (size_t)j * 512 * 1024, OB,
                                 nullptr, nullptr, ARGS.diff_subln + j * 128, lam, 1.f - lam_init, 0.125f * 1.4426950408889634f, ctl + l, 8};

#ifndef SKIP_ATTN
 attn_phase<2, 64, 128, false, 1>(lds, a);
#ifdef PROBE_ATT
 GSYNC(); a.ctr = ctl + 4 + l; attn_phase<2, 64, 128, false, 1>(lds, a);
#endif
#endif
 }
                    GSYNC();
                    { pg8::Gemm gm{OB, (const bf16*)(ws + OFF_DWO + j * SZ_WO), NTOK, DM, DM}; pg8::StaticOrder S; S.init(NTOK, DM, G, bx);
                      EpiResid E{out, xso, out, modl + 5 * 1024, 1.f, ARGS.norm_g + (size_t)(l * 3 + 2) * DM, modl + 7 * 1024, SSLOT(l * 3 + 2), H};

#if !defined(ONLY) || ONLY == 2
      pg8::gemm_phase<EpiResid, pg8::StaticOrder, true, true>(lds, gm, S, E);
#endif
 }
                    if (defer_ok()) { if (bx >= IDLE_160) deferred_slot(lds, qpos, QUOTA_OUT_PROJ, IDLE_160); qpos += QUOTA_OUT_PROJ; }
                    GSYNC();
                } else {
                    { pg8::Gemm gm{H, (const bf16*)(ws + OFF_MDOWN + j * SZ_MDOWN), NTOK, 1280, DM}; pg8::StaticOrder S; S.init(NTOK, 1280, G, bx);
                      EpiDownRaw E{(float*)(ws + OFF_DOWN), SSLOT(l * 3 + 1), SHWSLOT(l * 3 + 1)};

#if !defined(ONLY) || ONLY == 3
      pg8::gemm_phase<EpiDownRaw, pg8::StaticOrder, true, true>(lds, gm, S, E);
#endif
 }
                    GSYNC();
                    mla_norm_phase(j);
                    GSYNC();
                    { pg8::Gemm gm{(const bf16*)(ws + OFF_CQ), (const bf16*)(ws + OFF_MQUP + j * SZ_MQUP), NTOK, 1536, 768}; pg8::StaticOrder S; S.init(NTOK, 1536, G, bx);
                      EpiBf16Plain E{QB, 1536};

#if !defined(ONLY) || ONLY == 4
      pg8::gemm_phase<EpiBf16Plain, pg8::StaticOrder, true, true>(lds, gm, S, E);
#endif
 }
                    { pg8::Gemm gm{(const bf16*)(ws + OFF_CKV + j * SZ_CKV), (const bf16*)(ws + OFF_MKVUP + j * SZ_MKVUP), NKV, 2048, 256}; pg8::StaticOrder S; S.init(NKV, 2048, G, bx);
                      EpiKVup E{KBUF, VBUF, ARGS.mla_k_norm + j * 96, (const float*)(ws + OFF_KPE + j * SZ_KPE), (const float*)(ws + OFF_KPSS + j * SZ_KPSS), (const float*)(ws + OFF_TABM)};

#if !defined(ONLY) || ONLY == 5
      pg8::gemm_phase<EpiKVup, pg8::StaticOrder, true, true>(lds, gm, S, E);
#endif
 }
                    GSYNC();
                    { AttnArgs a{QB, 1536, KBUF, 1536, VBUF, 1024, KBUF + (size_t)NTOK * 1536, VBUF + (size_t)NTOK * 1024, OB,
                                 ARGS.mla_q_norm + j * 96, (const float*)(ws + OFF_TABM), nullptr, 0.f, 0.f, 0.10206207261596575f * 1.4426950408889634f, ctl + l, 16};

#ifndef SKIP_ATTN2
 attn_phase<1, 96, 64, true, 2>(lds, a);
#ifdef PROBE_ATT
 GSYNC(); a.ctr = ctl + 4 + l; attn_phase<1, 96, 64, true, 2>(lds, a);
#endif
#endif
 }
                    GSYNC();
                    { pg8::Gemm gm{OB, (const bf16*)(ws + OFF_MWO + j * SZ_WO), NTOK, DM, DM}; pg8::StaticOrder S; S.init(NTOK, DM, G, bx);
                      EpiResid E{out, xso, out, modl + 5 * 1024, 1.f, ARGS.norm_g + (size_t)(l * 3 + 2) * DM, modl + 7 * 1024, SSLOT(l * 3 + 2), H};

#if !defined(ONLY) || ONLY == 6
      pg8::gemm_phase<EpiResid, pg8::StaticOrder, true, true>(lds, gm, S, E);
#endif
 }
                    if (defer_ok()) { if (bx >= IDLE_160) deferred_slot(lds, qpos, QUOTA_OUT_PROJ, IDLE_160); qpos += QUOTA_OUT_PROJ; }
                    GSYNC();
                }
            }
            const bool first = (l == 0 && f == 0);
            { pg8::Gemm gm{H, (const bf16*)(ws + OFF_WIN + (size_t)(l * 2 + f) * SZ_WIN), NTOK, 2 * DFF, DM}; pg8::StaticOrder S; S.init(NTOK, 2 * DFF, G, bx);
              EpiSwiglu E{ACT, SSLOT(l * 3 + 2 * f), SHWSLOT(l * 3 + 2 * f)};

#if !defined(ONLY) || ONLY == 7
      pg8::gemm_phase<EpiSwiglu, pg8::StaticOrder, true, true>(lds, gm, S, E);
#endif
 }
            if (defer_ok()) { if (bx >= IDLE_FFN_IN) deferred_slot(lds, qpos, QUOTA_FFN_IN, IDLE_FFN_IN); qpos += QUOTA_FFN_IN; }
            GSYNC();
            { pg8::Gemm gm{ACT, (const bf16*)(ws + OFF_WOUT + (size_t)(l * 2 + f) * SZ_WOUT), NTOK, DM, DFF}; pg8::StaticOrder S; S.init(NTOK, DM, G, bx);
              const bool nonext = (l == 3 && f == 1);
              const float* gn = nonext ? (const float*)nullptr : (f == 0 ? ARGS.norm_g + (size_t)(l * 3 + 1) * DM : ARGS.norm_g + (size_t)((l + 1) * 3) * DM);
              const float* scn = f == 0 ? modl + 4 * 1024 : mod + (size_t)(l + 1) * 3 * NMOD + 1024;
              float* ssn = f == 0 ? SSLOT(l * 3 + 1) : SSLOT((l + 1) * 3);
              EpiResid E{first ? xp : out, first ? xs : xso, out, modl + (size_t)(2 + 6 * f) * 1024, 0.5f, gn, scn, ssn, H};

#if !defined(ONLY) || ONLY == 8
      pg8::gemm_phase<EpiResid, pg8::StaticOrder, true, true>(lds, gm, S, E);
#endif
 }
            if (defer_ok()) { if (bx >= IDLE_160) deferred_slot(lds, qpos, QUOTA_FFN_OUT, IDLE_160); qpos += QUOTA_FFN_OUT; }
            GSYNC();
        }
    }
}

#undef ws
#undef out
#undef mod
#undef H
#undef ACT
#undef QB
#undef KBUF
#undef VBUF
#undef OB
#undef ctl
#undef SSLOT
#undef SHWSLOT
#undef modl
#undef xp
#undef xs
#undef xso
extern "C" void kernel_launch(void* const* d_in, const int* in_sizes, int n_in, void* d_out, int out_size, void* d_ws, size_t ws_size, hipStream_t stream) {
    static int grid = 0;
    if (grid == 0) {
        if (n_in != 27 || (size_t)out_size != OUT_TOTAL || ws_size < WS_END) { fprintf(stderr, "kernel_launch: unexpected shapes (n_in %d, out %d, ws %zu, need %zu)\n", n_in, out_size, ws_size, (size_t)WS_END); grid = -1; return; }
        int dev = 0, cus = 0, per_cu = 0;
        hipGetDevice(&dev);
        hipDeviceGetAttribute(&cus, hipDeviceAttributeMultiprocessorCount, dev);
        hipFuncSetAttribute((const void*)mega_fwd, hipFuncAttributeMaxDynamicSharedMemorySize, LDS_BYTES);
        hipOccupancyMaxActiveBlocksPerMultiprocessor(&per_cu, (const void*)mega_fwd, NTHREADS, LDS_BYTES);
        if (per_cu < 1) { fprintf(stderr, "kernel_launch: occupancy query says %d blocks per CU\n", per_cu); grid = -1; return; }
        grid = cus * 1;
    }
    if (grid < 0) return;
    hipMemsetAsync((char*)d_ws + OFF_CTL, 0, 32768, stream);
    Args a{};
    const float** ap = (const float**)&a;
    for (int i = 0; i < 27; ++i) ap[i] = (const float*)d_in[i];
    a.out = (float*)d_out; a.ws = (unsigned char*)d_ws;
    void* args[] = {&a};
    hipError_t e = hipLaunchCooperativeKernel((const void*)mega_fwd, dim3(grid), dim3(NTHREADS), args, LDS_BYTES, stream);
    if (e != hipSuccess) fprintf(stderr, "cooperative launch failed: %s (grid %d)\n", hipGetErrorString(e), grid);
}
```
